# Optimizing an MI355X kernel written in HIP

```python
import math
import jax, jax.numpy as jnp
from jax import lax
import numpy as np

D_MODEL = 2048
BATCH = 4
SEQ = 2048
DEPTH = 2

N_META = 16
CHUNK = 128
PAD = CHUNK - N_META
A_HEAD_DIM = 64
A_V_DIM = 2 * A_HEAD_DIM
A_HEADS = D_MODEL // A_V_DIM
A_QK = A_HEADS * 2 * A_HEAD_DIM
A_VW = A_HEADS * A_V_DIM
R_QK_DIM = 128
R_V_DIM = 2 * R_QK_DIM
R_HEADS = D_MODEL // R_V_DIM
R_QK = R_HEADS * R_QK_DIM
R_VW = R_HEADS * R_V_DIM
D_FF = 128 * ((8 * D_MODEL // 3 + 127) // 128)
CONV_W = 3
ROPE_THETA = 10000.0
ALPHA = (2 * DEPTH) ** 0.25
BETA = (8 * DEPTH) ** -0.25
EPS = 1e-5
NEG = -1e30

kernel_name = "hybrid_diffattn_retention_convffn_deepnorm"


def _split_points():
    sizes = (A_QK, A_QK, A_VW, R_QK, R_QK, R_VW, R_VW, D_MODEL, D_MODEL)
    return tuple(int(s) for s in np.cumsum(sizes)[:-1])


def _w_in_cols():
    return 2 * A_QK + A_VW + 2 * R_QK + 2 * R_VW + 2 * D_MODEL


def layer_norm(x, g, b):
    xf = x.astype(jnp.float32)
    mu = jnp.mean(xf, axis=-1, keepdims=True)
    var = jnp.mean(jnp.square(xf - mu), axis=-1, keepdims=True)
    y = (xf - mu) * lax.rsqrt(var + EPS)
    return (y * g.astype(jnp.float32) + b.astype(jnp.float32)).astype(x.dtype)


def rms_norm(x, g):
    xf = x.astype(jnp.float32)
    y = xf * lax.rsqrt(jnp.mean(jnp.square(xf), axis=-1, keepdims=True) + EPS)
    return (y * g.astype(jnp.float32)).astype(x.dtype)


def head_group_norm(x):
    xf = x.astype(jnp.float32)
    mu = jnp.mean(xf, axis=-1, keepdims=True)
    var = jnp.mean(jnp.square(xf - mu), axis=-1, keepdims=True)
    return ((xf - mu) * lax.rsqrt(var + EPS)).astype(x.dtype)


def rotary(t, pos, inv_freq):
    ang = pos.astype(jnp.float32)[:, None] * inv_freq[None, :]
    ang = jnp.concatenate([ang, ang], axis=-1)
    t1, t2 = jnp.split(t, 2, axis=-1)
    rot = jnp.concatenate([-t2, t1], axis=-1)
    return (t * jnp.cos(ang) + rot * jnp.sin(ang)).astype(t.dtype)


def diff_attention(q1, q2, k1, k2, v, lam):
    B, H, L, d = q1.shape
    nb = L // CHUNK
    scale = d ** -0.5
    kidx = jnp.arange(L)
    key_ok = kidx >= PAD

    def block(args):
        i, qb1, qb2 = args
        qidx = i * CHUNK + jnp.arange(CHUNK)
        allowed = (kidx[None, :] <= qidx[:, None]) & (key_ok[None, :] | (kidx[None, :] == qidx[:, None]))

        def probs(qb, k):
            s = jnp.einsum('bhqd,bhkd->bhqk', qb, k).astype(jnp.float32) * scale
            return jax.nn.softmax(jnp.where(allowed, s, NEG), axis=-1)

        a = probs(qb1, k1) - lam * probs(qb2, k2)
        return jnp.einsum('bhqk,bhkv->bhqv', a.astype(v.dtype), v)

    qb1 = q1.reshape(B, H, nb, CHUNK, d).transpose(2, 0, 1, 3, 4)
    qb2 = q2.reshape(B, H, nb, CHUNK, d).transpose(2, 0, 1, 3, 4)
    o = lax.map(block, (jnp.arange(nb), qb1, qb2))
    return o.transpose(1, 2, 0, 3, 4).reshape(B, H, L, v.shape[-1])


def retention(q, k, v, log_gamma):
    B, H, L, dk = q.shape
    dv = v.shape[-1]
    nc = L // CHUNK
    qc = q.reshape(B, H, nc, CHUNK, dk)
    kc = k.reshape(B, H, nc, CHUNK, dk)
    vc = v.reshape(B, H, nc, CHUNK, dv)
    p = jnp.arange(CHUNK, dtype=jnp.float32)
    diff = p[:, None] - p[None, :]
    lg = log_gamma[:, None, None]
    decay = jnp.where(diff >= 0, jnp.exp(lg * jnp.maximum(diff, 0.0)), 0.0)
    s = jnp.einsum('bhcnk,bhcmk->bhcnm', qc, kc) * decay[None, :, None]
    o_intra = jnp.einsum('bhcnm,bhcmv->bhcnv', s.astype(v.dtype), vc)
    k_tail = kc * jnp.exp(log_gamma[:, None] * (CHUNK - 1 - p))[None, :, None, :, None]
    kv = jnp.einsum('bhcmk,bhcmv->cbhkv', k_tail, vc).astype(jnp.float32)
    chunk_decay = jnp.exp(log_gamma * CHUNK)[None, :, None, None]

    def step(state, kv_c):
        return chunk_decay * state + kv_c, state

    _, prev = lax.scan(step, jnp.zeros((B, H, dk, dv), jnp.float32), kv)
    q_dec = qc * jnp.exp(log_gamma[:, None] * (p + 1.0))[None, :, None, :, None]
    o_cross = jnp.einsum('bhcnk,cbhkv->bhcnv', q_dec, prev)
    return (o_intra + o_cross).astype(v.dtype).reshape(B, H, L, dv)


def hybrid_mixer(h, pos, valid, layer, w_in, lam_q1, lam_k1, lam_q2, lam_k2,
                 subln_g, ret_gn_g, w_branch_a, w_branch_b, w_out):
    B, L, _ = h.shape
    proj = h @ w_in
    aq, ak, av, rq, rk, rv, rg, ga, gb = jnp.split(proj, _split_points(), axis=-1)

    a_freq = 1.0 / (ROPE_THETA ** (jnp.arange(0, A_HEAD_DIM, 2, dtype=jnp.float32) / A_HEAD_DIM))

    def pair_heads(t):
        return t.reshape(B, L, A_HEADS, 2, A_HEAD_DIM).transpose(0, 2, 3, 1, 4)

    qa = rotary(pair_heads(aq), pos, a_freq)
    ka = rotary(pair_heads(ak), pos, a_freq)
    va = av.reshape(B, L, A_HEADS, A_V_DIM).transpose(0, 2, 1, 3)
    lam_init = 0.8 - 0.6 * math.exp(-0.3 * layer)
    lam = (jnp.exp(jnp.sum(lam_q1.astype(jnp.float32) * lam_k1.astype(jnp.float32)))
           - jnp.exp(jnp.sum(lam_q2.astype(jnp.float32) * lam_k2.astype(jnp.float32))) + lam_init)
    o_a = diff_attention(qa[:, :, 0], qa[:, :, 1], ka[:, :, 0], ka[:, :, 1], va, lam)
    o_a = rms_norm(o_a, subln_g) * (1.0 - lam_init)
    branch_a = o_a.transpose(0, 2, 1, 3).reshape(B, L, A_VW) @ w_branch_a

    r_freq = 1.0 / (ROPE_THETA ** jnp.linspace(0.0, 1.0, R_QK_DIM // 2, dtype=jnp.float32))

    def heads(t, dh):
        return t.reshape(B, L, R_HEADS, dh).transpose(0, 2, 1, 3)

    qr = rotary(heads(rq, R_QK_DIM), pos, r_freq)
    kr = rotary(heads(rk, R_QK_DIM), pos, r_freq) * (R_QK_DIM ** -0.5) * valid[None, None, :, None]
    vr = heads(rv, R_V_DIM)
    log_gamma = jnp.log(1.0 - 2.0 ** (-5.0 - jnp.arange(R_HEADS, dtype=jnp.float32)))
    o_r = head_group_norm(retention(qr, kr, vr, log_gamma))
    o_r = o_r.transpose(0, 2, 1, 3).reshape(B, L, R_VW) * ret_gn_g
    branch_b = (o_r * jax.nn.silu(rg)) @ w_branch_b

    merged = jax.nn.sigmoid(ga) * branch_a + jax.nn.sigmoid(gb) * branch_b
    return merged @ w_out


def conv_ffn(h, valid, w_up, conv_w, conv_b, w_down):
    L = h.shape[1]
    u = (h @ w_up) * valid[None, :, None]
    up = jnp.pad(u, ((0, 0), (CONV_W - 1, 0), (0, 0)))
    c = sum(up[:, j:j + L] * conv_w[j] for j in range(CONV_W)) + conv_b
    gate, val = jnp.split(c, 2, axis=-1)
    return (jax.nn.gelu(gate, approximate=False) * val) @ w_down


def setup_inputs(seed: int = 0) -> dict:
    key = jax.random.key(seed)
    ks = jax.random.split(key, 22)
    f32 = jnp.float32
    nrm = lambda k, shape, s: jax.random.normal(k, shape, f32) * s
    cols = _w_in_cols()
    col_scale = jnp.concatenate([
        jnp.ones((2 * A_QK,), f32), jnp.full((A_VW,), BETA, f32),
        jnp.ones((2 * R_QK,), f32), jnp.full((R_VW,), BETA, f32),
        jnp.ones((R_VW + 2 * D_MODEL,), f32)])
    return {
        "x": nrm(ks[0], (BATCH, SEQ, D_MODEL), 1.0),
        "meta_tokens": nrm(ks[1], (N_META, D_MODEL), 1.0),
        "ln_emb_g": 1.0 + nrm(ks[2], (D_MODEL,), 0.02),
        "ln_emb_b": nrm(ks[3], (D_MODEL,), 0.02),
        "w_in": nrm(ks[4], (DEPTH, D_MODEL, cols), D_MODEL ** -0.5) * col_scale,
        "lam_q1": nrm(ks[5], (DEPTH, A_HEAD_DIM), 0.1),
        "lam_k1": nrm(ks[6], (DEPTH, A_HEAD_DIM), 0.1),
        "lam_q2": nrm(ks[7], (DEPTH, A_HEAD_DIM), 0.1),
        "lam_k2": nrm(ks[8], (DEPTH, A_HEAD_DIM), 0.1),
        "subln_g": 1.0 + nrm(ks[9], (DEPTH, A_V_DIM), 0.02),
        "ret_gn_g": 1.0 + nrm(ks[10], (DEPTH, R_VW), 0.02),
        "w_branch_a": nrm(ks[11], (DEPTH, A_VW, D_MODEL), BETA * A_VW ** -0.5),
        "w_branch_b": nrm(ks[12], (DEPTH, R_VW, D_MODEL), BETA * R_VW ** -0.5),
        "w_out": nrm(ks[13], (DEPTH, D_MODEL, D_MODEL), BETA * D_MODEL ** -0.5),
        "ln1_g": 1.0 + nrm(ks[14], (DEPTH, D_MODEL), 0.02),
        "ln1_b": nrm(ks[15], (DEPTH, D_MODEL), 0.02),
        "w_up": nrm(ks[16], (DEPTH, D_MODEL, 2 * D_FF), D_MODEL ** -0.5),
        "conv_w": nrm(ks[17], (DEPTH, CONV_W, 2 * D_FF), CONV_W ** -0.5),
        "conv_b": nrm(ks[18], (DEPTH, 2 * D_FF), 0.02),
        "w_down": nrm(ks[19], (DEPTH, D_FF, D_MODEL), BETA * D_FF ** -0.5),
        "ln2_g": 1.0 + nrm(ks[20], (DEPTH, D_MODEL), 0.02),
        "ln2_b": nrm(ks[21], (DEPTH, D_MODEL), 0.02),
    }


def reference(x, meta_tokens, ln_emb_g, ln_emb_b, w_in, lam_q1, lam_k1, lam_q2, lam_k2,
              subln_g, ret_gn_g, w_branch_a, w_branch_b, w_out, ln1_g, ln1_b,
              w_up, conv_w, conv_b, w_down, ln2_g, ln2_b):
    B = x.shape[0]
    filler = jnp.zeros((B, PAD, D_MODEL), x.dtype)
    meta = jnp.broadcast_to(meta_tokens.astype(x.dtype)[None], (B, N_META, D_MODEL))
    h = jnp.concatenate([filler, meta, x], axis=1)
    L = h.shape[1]
    idx = jnp.arange(L)
    pos = idx - PAD
    valid = (idx >= PAD).astype(x.dtype)
    h = layer_norm(h, ln_emb_g, ln_emb_b)
    for l in range(DEPTH):
        mix = hybrid_mixer(h, pos, valid, l, w_in[l], lam_q1[l], lam_k1[l], lam_q2[l], lam_k2[l],
                           subln_g[l], ret_gn_g[l], w_branch_a[l], w_branch_b[l], w_out[l])
        h = layer_norm(ALPHA * h + mix, ln1_g[l], ln1_b[l])
        ffn = conv_ffn(h, valid, w_up[l], conv_w[l], conv_b[l], w_down[l])
        h = layer_norm(ALPHA * h + ffn, ln2_g[l], ln2_b[l])
    return h[:, PAD + N_META:]
```

```cpp
#include <hip/hip_runtime.h>
#include <hip/hip_cooperative_groups.h>
#include <cstdio>
namespace cg = cooperative_groups;

#define LAS __attribute__((address_space(3)))
#define DI __device__ __forceinline__
typedef unsigned short bf16_t;
typedef short bf16x8 __attribute__((ext_vector_type(8)));
typedef short s16x4 __attribute__((ext_vector_type(4)));
typedef float f32x2 __attribute__((ext_vector_type(2)));
typedef float f32x4 __attribute__((ext_vector_type(4)));
typedef float f32x16 __attribute__((ext_vector_type(16)));
typedef unsigned u32x2 __attribute__((ext_vector_type(2)));
typedef unsigned u32x4 __attribute__((ext_vector_type(4)));
typedef __bf16 bf2_t __attribute__((ext_vector_type(2)));

constexpr int D = 2048, NB = 4, LP = 2176, MROWS = NB * LP, PADR = 112, SEQ = 2048;
constexpr int WIN = 16384, DFF = 5504, DFF2 = 11008;
constexpr int PLD = WIN + 128;
constexpr float ALPHA = 1.41421356237f, EPS = 1e-5f;
constexpr int C_AQ = 0, C_AK = 2048, C_AV = 4096, C_RQ = 6144, C_RK = 7168, C_RV = 8192, C_RG = 10240, C_GA = 12288, C_GB = 14336;

constexpr size_t WS_CTR = 0;
constexpr size_t WS_LAM = 256;
constexpr size_t WS_BAR = 512;
constexpr size_t WS_QCTR = 512 + 5120;
constexpr size_t WS_LNCNT = 512 + 8192;
constexpr size_t WS_TAB = 512 + 8192 + 2048;
constexpr size_t WS_TA = 512 + 16384;
constexpr size_t WS_TR = WS_TA + (size_t)LP * 32 * 2 * 4;
constexpr size_t WS_WIN = WS_TR + (size_t)LP * 64 * 2 * 4;
constexpr size_t SZ_WIN = (size_t)WIN * D * 2;
constexpr size_t WS_WA = WS_WIN + 2 * SZ_WIN;
constexpr size_t SZ_SQ = (size_t)D * D * 2;
constexpr size_t WS_WB = WS_WA + 2 * SZ_SQ;
constexpr size_t WS_WO = WS_WB + 2 * SZ_SQ;
constexpr size_t WS_WUP = WS_WO + 2 * SZ_SQ;
constexpr size_t SZ_WUP = (size_t)DFF2 * D * 2;
constexpr size_t WS_WDN = WS_WUP + 2 * SZ_WUP;
constexpr size_t SZ_WDN = (size_t)D * DFF * 2;
constexpr size_t WS_HF = WS_WDN + 2 * SZ_WDN;
constexpr size_t WS_HB = WS_HF + (size_t)MROWS * D * 4;
constexpr size_t WS_P = WS_HB + (size_t)MROWS * D * 2;
constexpr size_t WS_OA = WS_P + (size_t)MROWS * PLD * 2;
constexpr size_t WS_OR = WS_OA + (size_t)MROWS * D * 2;
constexpr size_t WS_MG = WS_OR + (size_t)MROWS * D * 2;
constexpr size_t WS_PRE = WS_MG + (size_t)MROWS * D * 2;
constexpr size_t WS_ACT = WS_PRE + (size_t)MROWS * D * 4;
constexpr size_t WS_STATS = WS_ACT + (size_t)MROWS * DFF * 2;
constexpr size_t WS_END = WS_STATS + (size_t)(32 * 8 * 256 + 64 * 16) * 8;

#define REP_P0 1
#define REP_INPROJ 1
#define REP_ATTN 1
#define REP_MISC 1
#ifndef PMASK
#define PMASK 0xffff
#endif
constexpr int LDS_BYTES = 131072 + 1024;
constexpr int LDS_MISC = 131072;

struct Params { const float* in[22]; float* out; unsigned char* ws; };

DI int opaque_tid() { int t = threadIdx.x; asm volatile("" : "+v"(t)); return t; }
DI float shx(float v, int mask) { const int l = opaque_tid() & 63; return __int_as_float(__builtin_amdgcn_ds_bpermute((l ^ mask) << 2, __float_as_int(v))); }
DI float bf2f(unsigned h) { return __uint_as_float(h << 16); }
DI unsigned pk2(float lo, float hi) { f32x2 v = {lo, hi}; bf2_t b = __builtin_convertvector(v, bf2_t); return __builtin_bit_cast(unsigned, b); }
DI bf16_t f2bf(float x) { return (bf16_t)(pk2(x, 0.f) & 0xffffu); }
DI float wave_sum(float v) { for (int o = 32; o; o >>= 1) v += shx(v, o); return v; }
DI int crow(int i, int h) { return (i & 3) + 8 * (i >> 2) + 4 * h; }
DI float fexp2(float x) { return __builtin_amdgcn_exp2f(x); }
DI float sigmoidf_(float x) { return __builtin_amdgcn_rcpf(1.0f + fexp2(-1.4426950408889634f * x)); }
#define MFMA32(a, b, c) __builtin_amdgcn_mfma_f32_32x32x16_bf16((a), (b), (c), 0, 0, 0)
template <int OFF> DI s16x4 tr_read(unsigned addr) { s16x4 r; asm volatile("ds_read_b64_tr_b16 %0, %1 offset:%2" : "=&v"(r) : "v"(addr), "i"(OFF) : "memory"); return r; }
#define LGKM0() do { asm volatile("s_waitcnt lgkmcnt(0)" ::: "memory"); __builtin_amdgcn_sched_barrier(0); } while (0)
#define PK8(L, H) (bf16x8){L[0], L[1], L[2], L[3], H[0], H[1], H[2], H[3]}
DI bf16x8 pack8(float a0, float a1, float a2, float a3, float a4, float a5, float a6, float a7) {
    u32x4 w; w.x = pk2(a0, a1); w.y = pk2(a2, a3); w.z = pk2(a4, a5); w.w = pk2(a6, a7); return __builtin_bit_cast(bf16x8, w);
}


DI unsigned ab_ld(unsigned* p) { return __hip_atomic_load(p, __ATOMIC_RELAXED, __HIP_MEMORY_SCOPE_AGENT); }
DI unsigned ab_add(unsigned* p, unsigned v) { return __hip_atomic_fetch_add(p, v, __ATOMIC_RELAXED, __HIP_MEMORY_SCOPE_AGENT); }
#define AB_SPIN(cond) do { unsigned _sp = 0; while (cond) { __builtin_amdgcn_s_sleep(1); if (++_sp > (1u << 24)) break; } } while (0)
DI void fast_barrier(unsigned* bar, unsigned epoch) {
    asm volatile("s_waitcnt vmcnt(0)" ::: "memory");
    __syncthreads();
    if (threadIdx.x == 0) {
        const unsigned G = gridDim.x, g = blockIdx.x & 7u, ng = (G - g + 7u) >> 3, ngroups = G < 8u ? G : 8u;
        __builtin_amdgcn_fence(__ATOMIC_RELEASE, "agent");
        asm volatile("s_waitcnt vmcnt(0)" ::: "memory");
        unsigned* sub = bar + 64 * (1 + g); unsigned* gen = bar + 64 * (9 + g); unsigned* top = bar + 64 * 17; unsigned* topgen = bar + 64 * 18;
        const unsigned old = ab_add(sub, 1u);
        if (old + 1u == epoch * ng) {
            const unsigned ot = ab_add(top, 1u);
            if (ot + 1u == epoch * ngroups) ab_add(topgen, 1u);
            else AB_SPIN(ab_ld(topgen) < epoch);
            ab_add(gen, 1u);
        } else {
            AB_SPIN(ab_ld(gen) < epoch);
        }
        __builtin_amdgcn_fence(__ATOMIC_ACQUIRE, "agent");
        asm volatile("s_waitcnt vmcnt(0)" ::: "memory");
    }
    __syncthreads();
}

#define GAS __attribute__((address_space(1)))
DI unsigned char* wsl(unsigned char* ws) { GAS unsigned char* g = (GAS unsigned char*)ws; asm volatile("" : "+s"(g)); return (unsigned char*)g; }
DI const float* argp(unsigned char* ws, int i) {
    GAS const unsigned long long* t = (GAS const unsigned long long*)(ws + WS_TAB);
    asm volatile("" : "+s"(t));
    GAS const float* p = (GAS const float*)t[i];
    return (const float*)p;
}

DI f32x2 gelu_pk(f32x2 v) {
    const f32x2 av = __builtin_elementwise_abs(v), d = av * 0.2316418882f + 1.0f;
    f32x2 t; t.x = __builtin_amdgcn_rcpf(d.x); t.y = __builtin_amdgcn_rcpf(d.y);
    f32x2 q = t * 0.5307027145f + (-0.7265760135f); q = q * t + 0.7107068705f; q = q * t + (-0.142248368f); q = q * t + 0.127414796f; q = q * t;
    const f32x2 s = (v * v) * (-0.72134752044f);
    f32x2 e; e.x = __builtin_amdgcn_exp2f(s.x); e.y = __builtin_amdgcn_exp2f(s.y);
    const f32x2 m = v * (q * e), r = v - m;
    f32x2 o; o.x = v.x < 0.f ? m.x : r.x; o.y = v.y < 0.f ? m.y : r.y; return o;
}

DI void item_signal(unsigned* ctr) {
    asm volatile("s_waitcnt vmcnt(0)" ::: "memory");
    __syncthreads();
    if (threadIdx.x == 0) { __builtin_amdgcn_fence(__ATOMIC_RELEASE, "agent"); asm volatile("s_waitcnt vmcnt(0)" ::: "memory"); ab_add(ctr, 1u); }
}
DI void item_wait(unsigned* ctr, unsigned target) {
    if (threadIdx.x == 0) { AB_SPIN(ab_ld(ctr) < target); __builtin_amdgcn_fence(__ATOMIC_ACQUIRE, "agent"); asm volatile("s_waitcnt vmcnt(0)" ::: "memory"); }
    __syncthreads();
}

DI void st16_wt(void* p, f32x4 v) { asm volatile("s_nop 1\n\tglobal_store_dwordx4 %0, %1, off sc1\n\ts_nop 1" :: "v"(p), "v"(v) : "memory"); }
DI void st16_wt(void* p, u32x4 v) { asm volatile("s_nop 1\n\tglobal_store_dwordx4 %0, %1, off sc1\n\ts_nop 1" :: "v"(p), "v"(v) : "memory"); }
DI void st8_wt(void* p, f32x2 v) { __hip_atomic_store((unsigned long long*)p, __builtin_bit_cast(unsigned long long, v), __ATOMIC_RELAXED, __HIP_MEMORY_SCOPE_AGENT); }
DI void item_signal_wt(unsigned* ctr) {
    asm volatile("s_waitcnt vmcnt(0)" ::: "memory");
    __syncthreads();
    if (threadIdx.x == 0) ab_add(ctr, 1u);
}

DI int rowbase(int pm) { return (pm >> 3) * LP + 128 + (pm & 7) * 256; }
namespace pg8 {
constexpr int BM = 256, BK = 64, HALF = 128, HTB = HALF * BK * 2, STAGE_BYTES = 8 * HTB, NXCD = 8, WGM = 8;
DI int lds_byte(int r, int c) { const int st = (r >> 4) * 2 + (c >> 5), rr = r & 15, cc = c & 31, ob = rr * 64 + cc * 2; return st * 1024 + (ob ^ (((ob >> 9) & 1) << 5)); }
DI void stage_rc(int b, int& R, int& C) { const int st = b / 1024, sb = b % 1024, swz = sb ^ (((sb >> 9) & 1) << 5); R = (st >> 1) * 16 + swz / 64; C = (st & 1) * 32 + (swz % 64) / 2; }
DI int perm32(int rho) { const int n = rho >> 4, i = rho & 15; return 8 * (i >> 2) + 4 * n + (i & 3); }
struct Unit { int pm, pn; };
struct Gemm { const bf16_t* A; const bf16_t* Bt; int M, N, K; };
struct StaticOrder {
    int nM, nN, nwg, G, c;
    DI void init(int M, int N, int G_, int c_) { nM = M / BM; nN = N / BM; nwg = nM * nN; G = G_; c = c_; }
    DI bool next(int i, Unit& u) const {
        const long L = (long)i * G + c; if (L >= nwg) return false;
        int wgid = (int)L; { const int q = nwg / NXCD, r = nwg % NXCD, xcd = wgid % NXCD, off = wgid / NXCD; wgid = (xcd < r ? xcd * (q + 1) : r * (q + 1) + (xcd - r) * q) + off; }
        const int nig = WGM * nN, gid = wgid / nig, fm = gid * WGM, gsz = (nM - fm) < WGM ? (nM - fm) : WGM;
        u.pm = fm + ((wgid % nig) % gsz); u.pn = (wgid % nig) / gsz; return true;
    }
    DI void a_ready(const Unit&) const {}
    DI void done(const Unit&) const {}
};

template <class Epi, class Sched>
DI void gemm_phase(LAS unsigned char* lds, const Gemm g, const Sched& S, const Epi& E) {
    const int tid = opaque_tid(), wid = __builtin_amdgcn_readfirstlane(tid >> 6), lane = tid & 63, wr = wid >> 2, wc = wid & 3, fr = lane & 15, fq = lane >> 4;
    const int K = g.K, nt = K / BK;
    unsigned voffA[2], voffB[2];
#pragma unroll
    for (int i = 0; i < 2; ++i) { int R, C; stage_rc(tid * 16 + i * 8192, R, C); const int Rb = Epi::PERM ? ((R & ~31) + perm32(R & 31)) : R;
        voffA[i] = (unsigned)(R * K + C) * 2u; voffB[i] = (unsigned)(Rb * K + C) * 2u; }
    const size_t kstep = (size_t)(BK * 2);
    const size_t hstep = (size_t)HALF * K * 2;
    const size_t tstep = 2 * hstep;
    const unsigned ldsw = (unsigned)wid * 1024u;
    const int aoff = lds_byte(wr * 64 + fr, fq * 8), boff = lds_byte(wc * 32 + fr, fq * 8);
#define PG8_SA(b, h) (((b) * 2 + (h)) * HTB)
#define PG8_SB(b, h) ((4 + (b) * 2 + (h)) * HTB)
#define PG8_STAGE(bufoff, gbase, voff) do { _Pragma("unroll") for (int _i = 0; _i < 2; ++_i) \
        __builtin_amdgcn_global_load_lds((const unsigned*)((const char*)(gbase) + (voff)[_i]), (LAS unsigned*)(lds + (bufoff) + ldsw + _i * 8192), 16, 0, 0); } while (0)
#define PG8_LDA(dst, b, h) do { _Pragma("unroll") for (int m = 0; m < 4; ++m) _Pragma("unroll") for (int k = 0; k < 2; ++k) dst[m][k] = *(const LAS bf16x8*)(lds + PG8_SA(b, h) + aoff + m * 2048 + k * 1024); } while (0)
#define PG8_LDB(dst, b, h) do { _Pragma("unroll") for (int n = 0; n < 2; ++n) _Pragma("unroll") for (int k = 0; k < 2; ++k) dst[n][k] = *(const LAS bf16x8*)(lds + PG8_SB(b, h) + boff + n * 2048 + k * 1024); } while (0)
#define PG8_MMA(ai, bj, At, Bt) do { __builtin_amdgcn_s_setprio(1); _Pragma("unroll") for (int m = 0; m < 4; ++m) _Pragma("unroll") for (int n = 0; n < 2; ++n) _Pragma("unroll") for (int k = 0; k < 2; ++k) \
        acc[ai][bj][m][n] = __builtin_amdgcn_mfma_f32_16x16x32_bf16(Bt[n][k], At[m][k], acc[ai][bj][m][n], 0, 0, 0); __builtin_amdgcn_s_setprio(0); } while (0)
#define PG8_WAIT_V(n) asm volatile("s_waitcnt vmcnt(" #n ")" ::: "memory")
#define PG8_WAIT_L(n) asm volatile("s_waitcnt lgkmcnt(" #n ")" ::: "memory")
#define PG8_BAR __builtin_amdgcn_s_barrier()
#define PG8_SCHED __builtin_amdgcn_sched_barrier(0)
    Unit cur, nxt; int ui = 0;
    if (!S.next(0, cur)) return;
    f32x4 acc[2][2][4][2];
#pragma unroll
    for (int a = 0; a < 2; ++a)
#pragma unroll
        for (int b = 0; b < 2; ++b)
#pragma unroll
            for (int m = 0; m < 4; ++m)
#pragma unroll
                for (int n = 0; n < 2; ++n) acc[a][b][m][n] = (f32x4){0.f, 0.f, 0.f, 0.f};
    bf16x8 At[4][2], B0[2][2], B1[2][2];
    const char* cA = (const char*)g.A + (size_t)rowbase(cur.pm) * K * 2; const char* cB = (const char*)g.Bt + (size_t)cur.pn * tstep;
    S.a_ready(cur);
    PG8_STAGE(PG8_SB(0, 0), cB, voffB); PG8_STAGE(PG8_SA(0, 0), cA, voffA); PG8_STAGE(PG8_SB(0, 1), cB + hstep, voffB); PG8_STAGE(PG8_SA(0, 1), cA + hstep, voffA);
    if (wr == 1) PG8_BAR;
    PG8_WAIT_V(4); PG8_BAR;
    PG8_STAGE(PG8_SB(1, 0), cB + kstep, voffB); PG8_STAGE(PG8_SA(1, 0), cA + kstep, voffA); PG8_STAGE(PG8_SB(1, 1), cB + hstep + kstep, voffB);
    PG8_WAIT_V(6); PG8_BAR;
    for (;;) {
        const bool has_next = S.next(ui + 1, nxt);
        const char* nA = has_next ? (const char*)g.A + (size_t)rowbase(nxt.pm) * K * 2 : cA; const char* nB = has_next ? (const char*)g.Bt + (size_t)nxt.pn * tstep : cB;
        constexpr int NH = Epi::MID_HOOK ? 2 : 1;
#pragma nounroll
        for (int hh = 0; hh < NH; ++hh) {
        if constexpr (Epi::MID_HOOK) { if (hh == 1) { const int l2 = opaque_tid() & 63; E.mid(acc, cur, wr, wc, l2 & 15, l2 >> 4); } }
        for (int t = hh * (nt / NH); t < (hh + 1) * (nt / NH); t += 2) {
            const bool last = (t == nt - 2);
            const char* a1 = cA + (size_t)(t + 1) * kstep;
            const char* a2 = last ? nA : cA + (size_t)(t + 2) * kstep; const char* b2 = last ? nB : cB + (size_t)(t + 2) * kstep;
            const char* a3 = a2 + kstep; const char* b3 = b2 + kstep;
            if (last && has_next) S.a_ready(nxt);
            PG8_LDB(B0, 0, 0); PG8_SCHED; PG8_LDA(At, 0, 0); PG8_STAGE(PG8_SA(1, 1), a1 + hstep, voffA);
            PG8_WAIT_L(8); PG8_BAR; PG8_WAIT_L(0); PG8_MMA(0, 0, At, B0); PG8_BAR; PG8_SCHED;
            PG8_LDB(B1, 0, 1); PG8_STAGE(PG8_SB(0, 0), b2, voffB);
            PG8_BAR; PG8_WAIT_L(0); PG8_MMA(0, 1, At, B1); PG8_BAR;
            PG8_LDA(At, 0, 1); PG8_STAGE(PG8_SA(0, 0), a2, voffA);
            PG8_BAR; PG8_WAIT_L(0); PG8_MMA(1, 0, At, B0); PG8_BAR; PG8_SCHED;
            PG8_STAGE(PG8_SB(0, 1), b2 + hstep, voffB);
            PG8_WAIT_V(6); PG8_BAR; PG8_MMA(1, 1, At, B1); PG8_BAR;
            PG8_LDB(B0, 1, 0); PG8_SCHED; PG8_LDA(At, 1, 0); PG8_STAGE(PG8_SA(0, 1), a2 + hstep, voffA);
            PG8_WAIT_L(8); PG8_BAR; PG8_WAIT_L(0); PG8_MMA(0, 0, At, B0); PG8_BAR; PG8_SCHED;
            PG8_LDB(B1, 1, 1); PG8_STAGE(PG8_SB(1, 0), b3, voffB);
            PG8_BAR; PG8_WAIT_L(0); PG8_MMA(0, 1, At, B1); PG8_BAR;
            PG8_LDA(At, 1, 1); PG8_STAGE(PG8_SA(1, 0), a3, voffA);
            PG8_BAR; PG8_WAIT_L(0); PG8_MMA(1, 0, At, B0); PG8_BAR; PG8_SCHED;
            PG8_STAGE(PG8_SB(1, 1), b3 + hstep, voffB);
            PG8_WAIT_V(6); PG8_BAR; PG8_MMA(1, 1, At, B1); PG8_BAR;
        }
        }
        if constexpr (!Epi::AFTER_DRAIN) { const int l2 = opaque_tid() & 63; E(acc, cur, wr, wc, l2 & 15, l2 >> 4); } S.done(cur);
        if (!has_next) break;
#pragma unroll
        for (int a = 0; a < 2; ++a)
#pragma unroll
            for (int b = 0; b < 2; ++b)
#pragma unroll
                for (int m = 0; m < 4; ++m)
#pragma unroll
                    for (int n = 0; n < 2; ++n) acc[a][b][m][n] = (f32x4){0.f, 0.f, 0.f, 0.f};
        cur = nxt; cA = nA; cB = nB; ++ui;
    }
    PG8_WAIT_V(0);
    if (wr == 0) PG8_BAR;
    PG8_BAR;
    if constexpr (Epi::AFTER_DRAIN) { const int l2 = opaque_tid() & 63; E.fused(acc, cur, wr, wc, l2 & 15, l2 >> 4); }
#undef PG8_SA
#undef PG8_SB
#undef PG8_STAGE
#undef PG8_LDA
#undef PG8_LDB
#undef PG8_MMA
#undef PG8_WAIT_V
#undef PG8_WAIT_L
#undef PG8_BAR
#undef PG8_SCHED
}
}
using pg8::Unit;

struct EpiIn {
    static constexpr bool PERM = true, AFTER_DRAIN = false, MID_HOOK = false;
    bf16_t* P; const float* TA; const float* TR;
    template <int KIND> DI void g8k(int row, int col, f32x4 v0, f32x4 v1) const {
        const int l = row % LP;
        if (KIND == 0 || KIND == 2) {
            const float* t = (KIND == 0) ? TA + ((size_t)l * 32 + ((col & 63) >> 1)) * 2 : TR + ((size_t)l * 64 + ((col & 127) >> 1)) * 2;
            const f32x4 t0 = *(const f32x4*)t, t1 = *(const f32x4*)(t + 4);
            f32x4 w0, w1;
            w0[0] = v0[0] * t0[0] - v0[1] * t0[1]; w0[1] = v0[1] * t0[0] + v0[0] * t0[1];
            w0[2] = v0[2] * t0[2] - v0[3] * t0[3]; w0[3] = v0[3] * t0[2] + v0[2] * t0[3];
            w1[0] = v1[0] * t1[0] - v1[1] * t1[1]; w1[1] = v1[1] * t1[0] + v1[0] * t1[1];
            w1[2] = v1[2] * t1[2] - v1[3] * t1[3]; w1[3] = v1[3] * t1[2] + v1[2] * t1[3];
            v0 = w0; v1 = w1;
            if (KIND == 2 && col >= C_RK) { const float sc = (l >= PADR) ? 0.08838834764831845f : 0.0f; v0 *= sc; v1 *= sc; }
        }
        if (KIND == 3) {
#pragma unroll
            for (int j = 0; j < 4; ++j) { v0[j] = v0[j] * sigmoidf_(v0[j]); v1[j] = v1[j] * sigmoidf_(v1[j]); }
        }
        if (KIND == 4) {
#pragma unroll
            for (int j = 0; j < 4; ++j) { v0[j] = sigmoidf_(v0[j]); v1[j] = sigmoidf_(v1[j]); }
        }
        u32x4 w; w.x = pk2(v0[0], v0[1]); w.y = pk2(v0[2], v0[3]); w.z = pk2(v1[0], v1[1]); w.w = pk2(v1[2], v1[3]);
        *(u32x4*)(P + (size_t)row * PLD + col) = w;
    }
    DI void g8(int row, int col, f32x4 v0, f32x4 v1) const {
        const int pn = col >> 8;
        if (pn < 16) g8k<0>(row, col, v0, v1);
        else if (pn < 24) g8k<1>(row, col, v0, v1);
        else if (pn < 32) g8k<2>(row, col, v0, v1);
        else if (pn < 40) g8k<1>(row, col, v0, v1);
        else if (pn < 48) g8k<3>(row, col, v0, v1);
        else g8k<4>(row, col, v0, v1);
    }
    template <int KIND> DI void g8rot(int row, int col, f32x4 v0, f32x4 v1, const f32x4 t0, const f32x4 t1) const {
        f32x4 w0, w1;
        w0[0] = v0[0] * t0[0] - v0[1] * t0[1]; w0[1] = v0[1] * t0[0] + v0[0] * t0[1];
        w0[2] = v0[2] * t0[2] - v0[3] * t0[3]; w0[3] = v0[3] * t0[2] + v0[2] * t0[3];
        w1[0] = v1[0] * t1[0] - v1[1] * t1[1]; w1[1] = v1[1] * t1[0] + v1[0] * t1[1];
        w1[2] = v1[2] * t1[2] - v1[3] * t1[3]; w1[3] = v1[3] * t1[2] + v1[2] * t1[3];
        if (KIND == 2 && col >= C_RK) { const float sc = ((row % LP) >= PADR) ? 0.08838834764831845f : 0.0f; w0 *= sc; w1 *= sc; }
        u32x4 w; w.x = pk2(w0[0], w0[1]); w.y = pk2(w0[2], w0[3]); w.z = pk2(w1[0], w1[1]); w.w = pk2(w1[2], w1[3]);
        *(u32x4*)(P + (size_t)row * PLD + col) = w;
    }
    template <int KIND> DI void run(const f32x4 (&acc)[2][2][4][2], const Unit& u, int wr, int wc, int fr, int fq) const {
        int row0 = rowbase(u.pm) + wr * 64 + fr, col0 = u.pn * 256 + wc * 32 + 8 * fq;
        asm volatile("" : "+v"(row0), "+v"(col0));
        if constexpr (KIND == 0 || KIND == 2) {
#pragma unroll
            for (int ai = 0; ai < 2; ++ai) {
                f32x4 ta[4], tb[4];
#pragma unroll
                for (int m = 0; m < 4; ++m) {
                    const int l = (row0 + ai * 128 + m * 16) % LP;
                    const float* t = (KIND == 0) ? TA + ((size_t)l * 32 + ((col0 & 63) >> 1)) * 2 : TR + ((size_t)l * 64 + ((col0 & 127) >> 1)) * 2;
                    ta[m] = *(const f32x4*)t; tb[m] = *(const f32x4*)(t + 4);
                }
                __builtin_amdgcn_sched_barrier(0);
#pragma unroll
                for (int m = 0; m < 4; ++m)
#pragma unroll
                    for (int bj = 0; bj < 2; ++bj) { g8rot<KIND>(row0 + ai * 128 + m * 16, col0 + bj * 128, acc[ai][bj][m][0], acc[ai][bj][m][1], ta[m], tb[m]); __builtin_amdgcn_sched_barrier(0); }
            }
        } else {
#pragma unroll
            for (int ai = 0; ai < 2; ++ai)
#pragma unroll
                for (int m = 0; m < 4; ++m)
#pragma unroll
                    for (int bj = 0; bj < 2; ++bj) { g8k<KIND>(row0 + ai * 128 + m * 16, col0 + bj * 128, acc[ai][bj][m][0], acc[ai][bj][m][1]); __builtin_amdgcn_sched_barrier(0); }
        }
    }
    DI void operator()(const f32x4 (&acc)[2][2][4][2], const Unit& u, int wr, int wc, int fr, int fq) const {
        const int pn = u.pn;
        if (pn < 16) run<0>(acc, u, wr, wc, fr, fq);
        else if (pn < 24) run<1>(acc, u, wr, wc, fr, fq);
        else if (pn < 32) run<2>(acc, u, wr, wc, fr, fq);
        else if (pn < 40) run<1>(acc, u, wr, wc, fr, fq);
        else if (pn < 48) run<3>(acc, u, wr, wc, fr, fq);
        else run<4>(acc, u, wr, wc, fr, fq);
    }
};
template <int WHICH> struct EpiBr {
    static constexpr bool PERM = true, AFTER_DRAIN = false, MID_HOOK = false;
    const bf16_t* P; float* TMP; bf16_t* MG;
    DI void g8(int row, int col, f32x4 a0, f32x4 a1) const {
        const u32x4 gw = *(const u32x4*)(P + (size_t)row * PLD + (WHICH == 0 ? C_GA : C_GB) + col);
        f32x4 g0, g1;
        g0[0] = bf2f(gw.x & 0xffffu); g0[1] = bf2f(gw.x >> 16); g0[2] = bf2f(gw.y & 0xffffu); g0[3] = bf2f(gw.y >> 16);
        g1[0] = bf2f(gw.z & 0xffffu); g1[1] = bf2f(gw.z >> 16); g1[2] = bf2f(gw.w & 0xffffu); g1[3] = bf2f(gw.w >> 16);
        f32x4 v0 = a0 * g0, v1 = a1 * g1;
        float* tp = TMP + (size_t)row * D + col;
        if (WHICH == 0) { *(f32x4*)tp = v0; *(f32x4*)(tp + 4) = v1; }
        else {
            v0 += *(const f32x4*)tp; v1 += *(const f32x4*)(tp + 4);
            u32x4 w; w.x = pk2(v0[0], v0[1]); w.y = pk2(v0[2], v0[3]); w.z = pk2(v1[0], v1[1]); w.w = pk2(v1[2], v1[3]);
            *(u32x4*)(MG + (size_t)row * D + col) = w;
        }
    }
    DI void operator()(const f32x4 (&acc)[2][2][4][2], const Unit& u, int wr, int wc, int fr, int fq) const {
        const int row0 = rowbase(u.pm) + wr * 64 + fr, col0 = u.pn * 256 + wc * 32 + 8 * fq;
#pragma unroll
        for (int ai = 0; ai < 2; ++ai)
#pragma unroll
            for (int m = 0; m < 4; ++m)
#pragma unroll
                for (int bj = 0; bj < 2; ++bj) g8(row0 + ai * 128 + m * 16, col0 + bj * 128, acc[ai][bj][m][0], acc[ai][bj][m][1]);
    }
};
struct EpiRes {
    static constexpr bool PERM = false, AFTER_DRAIN = false, MID_HOOK = false;
    const float* HF; float* PRE;
    DI void g4(int row, int col, f32x4 a) const {
        const size_t o = (size_t)row * D + col;
        *(f32x4*)(PRE + o) = *(const f32x4*)(HF + o) * ALPHA + a;
    }
    DI void g8(int row, int col, f32x4 a0, f32x4 a1) const { g4(row, col, a0); g4(row, col + 4, a1); }
    DI void operator()(const f32x4 (&acc)[2][2][4][2], const Unit& u, int wr, int wc, int fr, int fq) const {
        const int row0 = rowbase(u.pm) + wr * 64 + fr, col0 = u.pn * 256 + wc * 32 + 4 * fq;
#pragma unroll
        for (int ai = 0; ai < 2; ++ai)
#pragma unroll
            for (int m = 0; m < 4; ++m)
#pragma unroll
                for (int bj = 0; bj < 2; ++bj)
#pragma unroll
                    for (int n = 0; n < 2; ++n) g4(row0 + ai * 128 + m * 16, col0 + bj * 128 + n * 16, acc[ai][bj][m][n]);
    }
};
struct EpiUp {
    static constexpr bool PERM = true, AFTER_DRAIN = false, MID_HOOK = false;
    bf16_t* U;
    DI void g8(int row, int col, f32x4 v0, f32x4 v1) const {
        u32x4 w; w.x = pk2(v0[0], v0[1]); w.y = pk2(v0[2], v0[3]); w.z = pk2(v1[0], v1[1]); w.w = pk2(v1[2], v1[3]);
        *(u32x4*)(U + (size_t)row * DFF2 + col) = w;
    }
    DI void operator()(const f32x4 (&acc)[2][2][4][2], const Unit& u, int wr, int wc, int fr, int fq) const {
        int row0 = rowbase(u.pm) + wr * 64 + fr, col0 = u.pn * 256 + wc * 32 + 8 * fq;
        asm volatile("" : "+v"(row0), "+v"(col0));
#pragma unroll
        for (int ai = 0; ai < 2; ++ai)
#pragma unroll
            for (int m = 0; m < 4; ++m)
#pragma unroll
                for (int bj = 0; bj < 2; ++bj) g8(row0 + ai * 128 + m * 16, col0 + bj * 128, acc[ai][bj][m][0], acc[ai][bj][m][1]);
    }
};

template <class Epi> DI void meta_gemm(const bf16_t* __restrict__ A, const bf16_t* __restrict__ Bt, int N, int K, const Epi& E, unsigned char* smem) {
    const int tid = opaque_tid(), wid = __builtin_amdgcn_readfirstlane(tid >> 6), lane = tid & 63, i16 = lane & 15, kq = lane >> 4;
    float* R = (float*)smem;
    const int nsteps = K / 32, s0 = (wid * nsteps) >> 3, s1 = ((wid + 1) * nsteps) >> 3;
    const bf16_t* ap = A + (size_t)(PADR + i16) * K + 8 * kq;
    for (int task = blockIdx.x; task < N / 32; task += gridDim.x) {
        const int cbase = task * 32;
        const bf16_t* w0 = Bt + (size_t)(cbase + 8 * (i16 >> 2) + (i16 & 3)) * K + 8 * kq;
        const bf16_t* w1 = w0 + (size_t)4 * K;
        f32x4 c0 = {0.f, 0.f, 0.f, 0.f}, c1 = {0.f, 0.f, 0.f, 0.f};
#pragma unroll 4
        for (int st = s0; st < s1; ++st) {
            const bf16x8 af = *(const bf16x8*)(ap + st * 32);
            const bf16x8 b0 = *(const bf16x8*)(w0 + st * 32), b1 = *(const bf16x8*)(w1 + st * 32);
            c0 = __builtin_amdgcn_mfma_f32_16x16x32_bf16(b0, af, c0, 0, 0, 0);
            c1 = __builtin_amdgcn_mfma_f32_16x16x32_bf16(b1, af, c1, 0, 0, 0);
        }
        *(f32x4*)(R + ((wid * 2 + 0) * 64 + lane) * 4) = c0;
        *(f32x4*)(R + ((wid * 2 + 1) * 64 + lane) * 4) = c1;
        __syncthreads();
        if (wid == 0) {
            f32x4 v0 = {0.f, 0.f, 0.f, 0.f}, v1 = {0.f, 0.f, 0.f, 0.f};
#pragma unroll
            for (int w = 0; w < 8; ++w) { v0 += *(const f32x4*)(R + ((w * 2 + 0) * 64 + lane) * 4); v1 += *(const f32x4*)(R + ((w * 2 + 1) * 64 + lane) * 4); }
            for (int b = 0; b < NB; ++b) E.g8(b * LP + PADR + i16, cbase + 8 * kq, v0, v1);
        }
        __syncthreads();
    }
}


struct EpiMerge {
    static constexpr bool PERM = true, AFTER_DRAIN = false, MID_HOOK = true;
    const bf16_t* P; bf16_t* MG;
    DI static void unpack8(const u32x4 gw, f32x4& g0, f32x4& g1) {
        g0[0] = bf2f(gw.x & 0xffffu); g0[1] = bf2f(gw.x >> 16); g0[2] = bf2f(gw.y & 0xffffu); g0[3] = bf2f(gw.y >> 16);
        g1[0] = bf2f(gw.z & 0xffffu); g1[1] = bf2f(gw.z >> 16); g1[2] = bf2f(gw.w & 0xffffu); g1[3] = bf2f(gw.w >> 16);
    }
    DI void mid(f32x4 (&acc)[2][2][4][2], const Unit& u, int wr, int wc, int fr, int fq) const {
        int row0 = rowbase(u.pm) + wr * 64 + fr, col0 = u.pn * 256 + wc * 32 + 8 * fq;
        asm volatile("" : "+v"(row0), "+v"(col0));
#pragma unroll
        for (int ai = 0; ai < 2; ++ai)
#pragma unroll
            for (int m = 0; m < 4; ++m)
#pragma unroll
                for (int bj = 0; bj < 2; ++bj) {
                    const bf16_t* gp = P + (size_t)(row0 + ai * 128 + m * 16) * PLD + col0 + bj * 128;
                    f32x4 a0, a1, b0, b1;
                    unpack8(*(const u32x4*)(gp + C_GA), a0, a1); unpack8(*(const u32x4*)(gp + C_GB), b0, b1);
#pragma unroll
                    for (int j = 0; j < 4; ++j) { acc[ai][bj][m][0][j] *= a0[j] * __builtin_amdgcn_rcpf(b0[j]); acc[ai][bj][m][1][j] *= a1[j] * __builtin_amdgcn_rcpf(b1[j]); }
                    asm volatile("" ::: "memory");
                }
    }
    DI void operator()(const f32x4 (&acc)[2][2][4][2], const Unit& u, int wr, int wc, int fr, int fq) const {
        int row0 = rowbase(u.pm) + wr * 64 + fr, col0 = u.pn * 256 + wc * 32 + 8 * fq;
        asm volatile("" : "+v"(row0), "+v"(col0));
#pragma unroll
        for (int ai = 0; ai < 2; ++ai)
#pragma unroll
            for (int m = 0; m < 4; ++m)
#pragma unroll
                for (int bj = 0; bj < 2; ++bj) {
                    const int row = row0 + ai * 128 + m * 16, col = col0 + bj * 128;
                    f32x4 b0, b1;
                    unpack8(*(const u32x4*)(P + (size_t)row * PLD + C_GB + col), b0, b1);
                    const f32x4 v0 = acc[ai][bj][m][0] * b0, v1 = acc[ai][bj][m][1] * b1;
                    u32x4 w; w.x = pk2(v0[0], v0[1]); w.y = pk2(v0[2], v0[3]); w.z = pk2(v1[0], v1[1]); w.w = pk2(v1[2], v1[3]);
                    *(u32x4*)(MG + (size_t)row * D + col) = w;
                }
    }
};
DI void meta_gemm_merge(const bf16_t* __restrict__ A, const bf16_t* __restrict__ Bt, const EpiMerge& E, unsigned char* smem) {
    const int tid = opaque_tid(), wid = __builtin_amdgcn_readfirstlane(tid >> 6), lane = tid & 63, i16 = lane & 15, kq = lane >> 4;
    float* R = (float*)smem;
    constexpr int K2 = 2 * D, nsteps = K2 / 32;
    const int s0 = (wid * nsteps) >> 3, s1 = ((wid + 1) * nsteps) >> 3;
    const bf16_t* ap = A + (size_t)(PADR + i16) * K2 + 8 * kq;
    const int task = blockIdx.x;
    if (task >= D / 32) return;
    const int cbase = task * 32;
    const bf16_t* w0 = Bt + (size_t)(cbase + 8 * (i16 >> 2) + (i16 & 3)) * K2 + 8 * kq;
    const bf16_t* w1 = w0 + (size_t)4 * K2;
    f32x4 c0 = {0.f, 0.f, 0.f, 0.f}, c1 = {0.f, 0.f, 0.f, 0.f};
#pragma unroll 4
    for (int st = s0; st < s1; ++st) {
        const bf16x8 af = *(const bf16x8*)(ap + st * 32);
        const bf16x8 b0 = *(const bf16x8*)(w0 + st * 32), b1 = *(const bf16x8*)(w1 + st * 32);
        c0 = __builtin_amdgcn_mfma_f32_16x16x32_bf16(b0, af, c0, 0, 0, 0);
        c1 = __builtin_amdgcn_mfma_f32_16x16x32_bf16(b1, af, c1, 0, 0, 0);
    }
    *(f32x4*)(R + ((wid * 2 + 0) * 64 + lane) * 4) = c0;
    *(f32x4*)(R + ((wid * 2 + 1) * 64 + lane) * 4) = c1;
    __syncthreads();
    if (wid == 0) {
        f32x4 a0 = {0.f, 0.f, 0.f, 0.f}, a1 = a0, b0 = a0, b1 = a0;
#pragma unroll
        for (int w = 0; w < 4; ++w) { a0 += *(const f32x4*)(R + ((w * 2 + 0) * 64 + lane) * 4); a1 += *(const f32x4*)(R + ((w * 2 + 1) * 64 + lane) * 4); }
#pragma unroll
        for (int w = 4; w < 8; ++w) { b0 += *(const f32x4*)(R + ((w * 2 + 0) * 64 + lane) * 4); b1 += *(const f32x4*)(R + ((w * 2 + 1) * 64 + lane) * 4); }
        const int col = cbase + 8 * kq;
        const bf16_t* gp = E.P + (size_t)(PADR + i16) * PLD + col;
        f32x4 ga0, ga1, gb0, gb1;
        EpiMerge::unpack8(*(const u32x4*)(gp + C_GA), ga0, ga1); EpiMerge::unpack8(*(const u32x4*)(gp + C_GB), gb0, gb1);
        const f32x4 v0 = a0 * ga0 + b0 * gb0, v1 = a1 * ga1 + b1 * gb1;
        u32x4 w; w.x = pk2(v0[0], v0[1]); w.y = pk2(v0[2], v0[3]); w.z = pk2(v1[0], v1[1]); w.w = pk2(v1[2], v1[3]);
        for (int bb = 0; bb < NB; ++bb) *(u32x4*)(E.MG + (size_t)(bb * LP + PADR + i16) * D + col) = w;
    }
    __syncthreads();
}

struct EpiLN {
    static constexpr bool PERM = false, AFTER_DRAIN = true, MID_HOOK = false;
    float* HF; bf16_t* HB; float* OUT; const float* g; const float* b; float* STATS; unsigned* cnt; unsigned char* smem;
    DI void fused(f32x4 (&acc)[2][2][4][2], const Unit& u, int wr, int wc, int fr, int fq) const {
        const int tid = opaque_tid();
        const int rb = rowbase(u.pm), rl0 = wr * 64 + fr, col0 = u.pn * 256 + wc * 32 + 4 * fq;
        float* part = (float*)smem;
        float* mr = part + 2048;
#pragma unroll
        for (int ai = 0; ai < 2; ++ai)
#pragma unroll
            for (int m = 0; m < 4; ++m) {
                const int rl = rl0 + ai * 128 + m * 16;
                const size_t ro = (size_t)(rb + rl) * D + col0;
                float sm = 0.f, sq = 0.f;
#pragma unroll
                for (int bj = 0; bj < 2; ++bj)
#pragma unroll
                    for (int n = 0; n < 2; ++n) {
                        const f32x4 x = *(const f32x4*)(HF + ro + bj * 128 + n * 16) * ALPHA + acc[ai][bj][m][n];
                        acc[ai][bj][m][n] = x;
                        sm += (x[0] + x[1]) + (x[2] + x[3]); sq += (x[0] * x[0] + x[1] * x[1]) + (x[2] * x[2] + x[3] * x[3]);
                    }
                sm += shx(sm, 16); sq += shx(sq, 16);
                sm += shx(sm, 32); sq += shx(sq, 32);
                if (fq == 0) { part[(wc * 256 + rl) * 2] = sm; part[(wc * 256 + rl) * 2 + 1] = sq; }
            }
        __syncthreads();
        if (tid < 256) {
            float S = 0.f, Q = 0.f;
#pragma unroll
            for (int w = 0; w < 4; ++w) { S += part[(w * 256 + tid) * 2]; Q += part[(w * 256 + tid) * 2 + 1]; }
            f32x2 v = {S, Q};
            st8_wt(STATS + ((size_t)(u.pm * 8 + u.pn) * 256 + tid) * 2, v);
        }
        asm volatile("s_waitcnt vmcnt(0)" ::: "memory");
        __syncthreads();
        if (tid == 0) {
            ab_add(cnt + u.pm, 1u);
            AB_SPIN(ab_ld(cnt + u.pm) < 8u);
            __builtin_amdgcn_fence(__ATOMIC_ACQUIRE, "agent"); asm volatile("s_waitcnt vmcnt(0)" ::: "memory");
        }
        __syncthreads();
        if (tid < 256) {
            float S = 0.f, Q = 0.f;
#pragma unroll
            for (int p = 0; p < 8; ++p) { const f32x2 v = *(const f32x2*)(STATS + ((size_t)(u.pm * 8 + p) * 256 + tid) * 2); S += v[0]; Q += v[1]; }
            const float mean = S * (1.0f / D), var = fmaxf(Q * (1.0f / D) - mean * mean, 0.f);
            mr[tid * 2] = mean; mr[tid * 2 + 1] = rsqrtf(var + EPS);
        }
        __syncthreads();
        f32x4 gv[2][2], bv[2][2];
#pragma unroll
        for (int bj = 0; bj < 2; ++bj)
#pragma unroll
            for (int n = 0; n < 2; ++n) { gv[bj][n] = *(const f32x4*)(g + col0 + bj * 128 + n * 16); bv[bj][n] = *(const f32x4*)(b + col0 + bj * 128 + n * 16); }
#pragma unroll
        for (int ai = 0; ai < 2; ++ai)
#pragma unroll
            for (int m = 0; m < 4; ++m) {
                const int rl = rl0 + ai * 128 + m * 16, row = rb + rl;
                const float mean = mr[rl * 2], rstd = mr[rl * 2 + 1];
#pragma unroll
                for (int bj = 0; bj < 2; ++bj)
#pragma unroll
                    for (int n = 0; n < 2; ++n) {
                        const int col = col0 + bj * 128 + n * 16;
                        const f32x4 y = (acc[ai][bj][m][n] - mean) * rstd * gv[bj][n] + bv[bj][n];
                        if (OUT) { const int bb = row / LP, l = row % LP; *(f32x4*)(OUT + ((size_t)bb * SEQ + (l - 128)) * D + col) = y; }
                        else {
                            *(f32x4*)(HF + (size_t)row * D + col) = y;
                            u32x2 w; w.x = pk2(y[0], y[1]); w.y = pk2(y[2], y[3]);
                            *(u32x2*)(HB + (size_t)row * D + col) = w;
                        }
                    }
            }
        __syncthreads();
    }
};
DI void meta_gemm_ln(const bf16_t* __restrict__ A, const bf16_t* __restrict__ Bt, int K, const EpiLN& E, unsigned char* smem) {
    const int tid = opaque_tid(), wid = __builtin_amdgcn_readfirstlane(tid >> 6), lane = tid & 63, i16 = lane & 15, kq = lane >> 4;
    float* R = (float*)smem;
    const int nsteps = K / 32, s0 = (wid * nsteps) >> 3, s1 = ((wid + 1) * nsteps) >> 3;
    const bf16_t* ap = A + (size_t)(PADR + i16) * K + 8 * kq;
    const int task = blockIdx.x;
    if (task >= D / 32) return;
    const int cbase = task * 32;
    const bf16_t* w0 = Bt + (size_t)(cbase + 8 * (i16 >> 2) + (i16 & 3)) * K + 8 * kq;
    const bf16_t* w1 = w0 + (size_t)4 * K;
    f32x4 c0 = {0.f, 0.f, 0.f, 0.f}, c1 = {0.f, 0.f, 0.f, 0.f};
#pragma unroll 4
    for (int st = s0; st < s1; ++st) {
        const bf16x8 af = *(const bf16x8*)(ap + st * 32);
        const bf16x8 b0 = *(const bf16x8*)(w0 + st * 32), b1 = *(const bf16x8*)(w1 + st * 32);
        c0 = __builtin_amdgcn_mfma_f32_16x16x32_bf16(b0, af, c0, 0, 0, 0);
        c1 = __builtin_amdgcn_mfma_f32_16x16x32_bf16(b1, af, c1, 0, 0, 0);
    }
    *(f32x4*)(R + ((wid * 2 + 0) * 64 + lane) * 4) = c0;
    *(f32x4*)(R + ((wid * 2 + 1) * 64 + lane) * 4) = c1;
    __syncthreads();
    if (wid == 0) {
        f32x4 v0 = {0.f, 0.f, 0.f, 0.f}, v1 = {0.f, 0.f, 0.f, 0.f};
#pragma unroll
        for (int w = 0; w < 8; ++w) { v0 += *(const f32x4*)(R + ((w * 2 + 0) * 64 + lane) * 4); v1 += *(const f32x4*)(R + ((w * 2 + 1) * 64 + lane) * 4); }
        const int col = cbase + 8 * kq;
        const size_t o0 = (size_t)(PADR + i16) * D + col;
        v0 += *(const f32x4*)(E.HF + o0) * ALPHA; v1 += *(const f32x4*)(E.HF + o0 + 4) * ALPHA;
        float sm = (v0[0] + v0[1]) + (v0[2] + v0[3]) + (v1[0] + v1[1]) + (v1[2] + v1[3]);
        float sq = (v0[0] * v0[0] + v0[1] * v0[1]) + (v0[2] * v0[2] + v0[3] * v0[3]) + (v1[0] * v1[0] + v1[1] * v1[1]) + (v1[2] * v1[2] + v1[3] * v1[3]);
        sm += shx(sm, 16); sq += shx(sq, 16);
        sm += shx(sm, 32); sq += shx(sq, 32);
        float* SM = E.STATS + (size_t)32 * 8 * 256 * 2;
        if (kq == 0) { f32x2 v = {sm, sq}; st8_wt(SM + (task * 16 + i16) * 2, v); }
        asm volatile("s_waitcnt vmcnt(0)" ::: "memory");
        if (lane == 0) {
            ab_add(E.cnt + 32, 1u);
            AB_SPIN(ab_ld(E.cnt + 32) < 64u);
            __builtin_amdgcn_fence(__ATOMIC_ACQUIRE, "agent"); asm volatile("s_waitcnt vmcnt(0)" ::: "memory");
        }
        __builtin_amdgcn_wave_barrier();
        float S = 0.f, Q = 0.f;
        for (int t = 0; t < 64; ++t) { const f32x2 v = *(const f32x2*)(SM + (t * 16 + i16) * 2); S += v[0]; Q += v[1]; }
        const float mean = S * (1.0f / D), var = fmaxf(Q * (1.0f / D) - mean * mean, 0.f), rstd = rsqrtf(var + EPS);
        const f32x4 g0 = *(const f32x4*)(E.g + col), g1 = *(const f32x4*)(E.g + col + 4), b0 = *(const f32x4*)(E.b + col), b1 = *(const f32x4*)(E.b + col + 4);
        const f32x4 y0 = (v0 - mean) * rstd * g0 + b0, y1 = (v1 - mean) * rstd * g1 + b1;
        u32x4 w; w.x = pk2(y0[0], y0[1]); w.y = pk2(y0[2], y0[3]); w.z = pk2(y1[0], y1[1]); w.w = pk2(y1[2], y1[3]);
        for (int bb = 0; bb < NB; ++bb) {
            const size_t o = (size_t)(bb * LP + PADR + i16) * D + col;
            *(f32x4*)(E.HF + o) = y0; *(f32x4*)(E.HF + o + 4) = y1;
            *(u32x4*)(E.HB + o) = w;
        }
    }
    __syncthreads();
}

DI int win_dst_row(int sc) {
    if (sc < 4096) { const int g = sc & ~63, j = sc & 63; return g + ((j & 31) << 1) + (j >> 5); }
    if (sc >= C_RQ && sc < C_RV) { const int g = sc & ~127, j = sc & 127; return g + ((j & 63) << 1) + (j >> 6); }
    return sc;
}
template <bool PERMW> DI void transpose_convert(const float* __restrict__ src, bf16_t* __restrict__ dst, int K, int N) {
    const int tid = opaque_tid(), wid = tid >> 6, lane = tid & 63;
    const int ntn = N / 64, ntk = (K + 255) / 256, ntile = ntn * ntk;
    for (int t = blockIdx.x; t < ntile; t += gridDim.x) {
        const int tn = t / ntk, tk = t % ntk;
        const int s4 = tn * 64 + (lane & 15) * 4, kb = tk * 256 + (wid * 4 + (lane >> 4)) * 8;
        if (kb < K) {
            f32x4 v[8];
#pragma unroll
            for (int j = 0; j < 8; ++j) v[j] = *(const f32x4*)(src + (size_t)(kb + j) * N + s4);
#pragma unroll
            for (int e = 0; e < 4; ++e) {
                const int n = PERMW ? win_dst_row(s4 + e) : (s4 + e);
                u32x4 w; w.x = pk2(v[0][e], v[1][e]); w.y = pk2(v[2][e], v[3][e]); w.z = pk2(v[4][e], v[5][e]); w.w = pk2(v[6][e], v[7][e]);
                *(u32x4*)(dst + (size_t)n * K + kb) = w;
            }
        }
    }
}

struct CvtTile { const float* src; bf16_t* dst; int K, N, t, ldd; bool perm; };
DI void cvt_load(const CvtTile& c, f32x4 (&v)[8], int& s4, int& kb, int wid, int lane) {
    const int ntk = (c.K + 255) / 256;
    const int tn = c.t / ntk, tk = c.t % ntk;
    s4 = tn * 64 + (lane & 15) * 4; kb = tk * 256 + (wid * 4 + (lane >> 4)) * 8;
    if (kb < c.K) {
#pragma unroll
        for (int j = 0; j < 8; ++j) v[j] = __builtin_nontemporal_load((const f32x4*)(c.src + (size_t)(kb + j) * c.N + s4));
    }
}
DI void cvt_store(const CvtTile& c, const f32x4 (&v)[8], int s4, int kb) {
    if (kb < c.K) {
#pragma unroll
        for (int e = 0; e < 4; ++e) {
            const int n = c.perm ? win_dst_row(s4 + e) : (s4 + e);
            u32x4 w; w.x = pk2(v[0][e], v[1][e]); w.y = pk2(v[2][e], v[3][e]); w.z = pk2(v[4][e], v[5][e]); w.w = pk2(v[6][e], v[7][e]);
            *(u32x4*)(c.dst + (size_t)n * c.ldd + kb) = w;
        }
    }
}
constexpr int CT_SQ = 32 * 8, CT_UP = 172 * 8, CT_DN = 32 * 22, CT_IN = 256 * 8;
constexpr int CT_L0 = 3 * CT_SQ + CT_UP + CT_DN, CT_TOTAL = 2 * CT_L0 + CT_IN, CT_PER_ITEM = 16, CT_ITEMS = (CT_TOTAL + CT_PER_ITEM - 1) / CT_PER_ITEM;
DI CvtTile deferred_tile(unsigned char* ws, int t) {
    CvtTile c; c.perm = false; c.ldd = 0;
    int l = 0;
    if (t >= CT_L0) { t -= CT_L0; l = 1;
        if (t < CT_IN) { c.src = argp(ws, 4) + (size_t)D * WIN; c.dst = (bf16_t*)(ws + WS_WIN + SZ_WIN); c.K = D; c.N = WIN; c.t = t; c.ldd = D; c.perm = true; return c; }
        t -= CT_IN; }
    if (t < CT_SQ) { c.src = argp(ws, 11) + (size_t)l * D * D; c.dst = (bf16_t*)(ws + WS_WA + l * 2 * SZ_SQ); c.K = D; c.N = D; c.t = t; c.ldd = 2 * D; return c; }
    t -= CT_SQ;
    if (t < CT_SQ) { c.src = argp(ws, 12) + (size_t)l * D * D; c.dst = (bf16_t*)(ws + WS_WA + l * 2 * SZ_SQ) + D; c.K = D; c.N = D; c.t = t; c.ldd = 2 * D; return c; }
    t -= CT_SQ;
    if (t < CT_SQ) { c.src = argp(ws, 13) + (size_t)l * D * D; c.dst = (bf16_t*)(ws + WS_WO + l * SZ_SQ); c.K = D; c.N = D; c.t = t; c.ldd = D; return c; }
    t -= CT_SQ;
    if (t < CT_UP) { c.src = argp(ws, 16) + (size_t)l * D * DFF2; c.dst = (bf16_t*)(ws + WS_WUP + l * SZ_WUP); c.K = D; c.N = DFF2; c.t = t; c.ldd = D; return c; }
    t -= CT_UP;
    c.src = argp(ws, 19) + (size_t)l * DFF * D; c.dst = (bf16_t*)(ws + WS_WDN + l * SZ_WDN); c.K = DFF; c.N = D; c.t = t; c.ldd = DFF; return c;
}
DI void convert_deferred_item(unsigned char* ws, int item) {
    const int tid = opaque_tid(), wid = tid >> 6, lane = tid & 63;
    const int t0 = item * CT_PER_ITEM;
#pragma nounroll
    for (int t = t0; t < t0 + CT_PER_ITEM; t += 4) {
        if (t >= CT_TOTAL) break;
        CvtTile c[4]; f32x4 v[4][8]; int s4[4], kb[4];
#pragma unroll
        for (int q = 0; q < 4; ++q) { c[q] = deferred_tile(ws, (t + q < CT_TOTAL) ? t + q : t); }
#pragma unroll
        for (int q = 0; q < 4; ++q) if (t + q < CT_TOTAL) cvt_load(c[q], v[q], s4[q], kb[q], wid, lane);
#pragma unroll
        for (int q = 0; q < 4; ++q) if (t + q < CT_TOTAL) cvt_store(c[q], v[q], s4[q], kb[q]);
    }
}

DI void ln_row(f32x4 (&x)[8], const float* __restrict__ g, const float* __restrict__ b, int lane) {
    float s = 0.f;
#pragma unroll
    for (int j = 0; j < 8; ++j) s += x[j][0] + x[j][1] + x[j][2] + x[j][3];
    const float mu = wave_sum(s) * (1.0f / D);
    float q = 0.f;
#pragma unroll
    for (int j = 0; j < 8; ++j) {
#pragma unroll
        for (int e = 0; e < 4; ++e) { const float d = x[j][e] - mu; q += d * d; }
    }
    const float rstd = rsqrtf(wave_sum(q) * (1.0f / D) + EPS);
#pragma unroll
    for (int j = 0; j < 8; ++j) { const int c = (j * 64 + lane) * 4; const f32x4 gv = *(const f32x4*)(g + c), bv = *(const f32x4*)(b + c);
#pragma unroll
        for (int e = 0; e < 4; ++e) x[j][e] = (x[j][e] - mu) * rstd * gv[e] + bv[e]; }
}
DI void store_h(const f32x4 (&x)[8], float* HF, bf16_t* HB, int row, int lane) {
#pragma unroll
    for (int j = 0; j < 8; ++j) { const int c = (j * 64 + lane) * 4;
        *(f32x4*)(HF + (size_t)row * D + c) = x[j];
        u32x2 w; w.x = pk2(x[j][0], x[j][1]); w.y = pk2(x[j][2], x[j][3]);
        *(u32x2*)(HB + (size_t)row * D + c) = w; }
}

template <int VT> DI void attn_pv2(f32x16& oa, f32x16& ob, unsigned vb, const bf16x8 (&pf)[2][2]) {
    const s16x4 al00 = tr_read<(0) * 320 + VT * 64>(vb), ah00 = tr_read<(8) * 320 + VT * 64>(vb);
    const s16x4 al01 = tr_read<(16) * 320 + VT * 64>(vb), ah01 = tr_read<(24) * 320 + VT * 64>(vb);
    const s16x4 al10 = tr_read<(32) * 320 + VT * 64>(vb), ah10 = tr_read<(40) * 320 + VT * 64>(vb);
    const s16x4 al11 = tr_read<(48) * 320 + VT * 64>(vb), ah11 = tr_read<(56) * 320 + VT * 64>(vb);
    const s16x4 bl00 = tr_read<(0) * 320 + VT * 64 + 64>(vb), bh00 = tr_read<(8) * 320 + VT * 64 + 64>(vb);
    const s16x4 bl01 = tr_read<(16) * 320 + VT * 64 + 64>(vb), bh01 = tr_read<(24) * 320 + VT * 64 + 64>(vb);
    const s16x4 bl10 = tr_read<(32) * 320 + VT * 64 + 64>(vb), bh10 = tr_read<(40) * 320 + VT * 64 + 64>(vb);
    const s16x4 bl11 = tr_read<(48) * 320 + VT * 64 + 64>(vb), bh11 = tr_read<(56) * 320 + VT * 64 + 64>(vb);
    LGKM0();
    oa = MFMA32(PK8(al00, ah00), pf[0][0], oa); ob = MFMA32(PK8(bl00, bh00), pf[0][0], ob);
    oa = MFMA32(PK8(al01, ah01), pf[0][1], oa); ob = MFMA32(PK8(bl01, bh01), pf[0][1], ob);
    oa = MFMA32(PK8(al10, ah10), pf[1][0], oa); ob = MFMA32(PK8(bl10, bh10), pf[1][0], ob);
    oa = MFMA32(PK8(al11, ah11), pf[1][1], oa); ob = MFMA32(PK8(bl11, bh11), pf[1][1], ob);
}
constexpr int AK_STR = 272, AV_STR = 320, AK_BUF = 64 * AK_STR, AV_BUF = 64 * AV_STR, AV_BASE = 2 * AK_BUF;
struct AttnCtx { int r, h, mp, qb, qrow; unsigned lds0, vlane; unsigned char* smem; };
DI void attn_S(f32x16 (&st)[2], const bf16x8 (&bq)[4], const AttnCtx& c, int kc) {
    bf16x8 kf[2][4];
    const unsigned char* kbase = c.smem + kc * AK_BUF + c.r * AK_STR + (c.mp * 64 + c.h * 8) * 2;
#pragma unroll
    for (int ksub = 0; ksub < 2; ++ksub)
#pragma unroll
        for (int ks = 0; ks < 4; ++ks) kf[ksub][ks] = *(const bf16x8*)(kbase + ksub * 32 * AK_STR + ks * 32);
#pragma unroll
    for (int i = 0; i < 16; ++i) { st[0][i] = 0.f; st[1][i] = 0.f; }
    LGKM0();
#pragma unroll
    for (int ks = 0; ks < 4; ++ks) { st[0] = MFMA32(kf[0][ks], bq[ks], st[0]); st[1] = MFMA32(kf[1][ks], bq[ks], st[1]); }
}
DI void attn_softmax(f32x16 (&st)[2], bf16x8 (&pf)[2][2], f32x16 (&ot)[4], float& mrun, float& lrun, const AttnCtx& c, int kt) {
    const float CS = 0.125f * 1.4426950408889634f;
    const bool need_mask = (kt < 2) || (kt >= 2 * c.qb);
#pragma unroll
    for (int ksub = 0; ksub < 2; ++ksub)
#pragma unroll
        for (int i = 0; i < 16; ++i) st[ksub][i] *= CS;
    if (need_mask) {
#pragma unroll
        for (int ksub = 0; ksub < 2; ++ksub)
#pragma unroll
            for (int i = 0; i < 16; ++i) {
                const int key = kt * 64 + ksub * 32 + crow(i, c.h);
                const bool ok = (key <= c.qrow) && (key >= PADR || key == c.qrow);
                st[ksub][i] = ok ? st[ksub][i] : -1e30f;
            }
    }
    float mx = -INFINITY;
#pragma unroll
    for (int ksub = 0; ksub < 2; ++ksub)
#pragma unroll
        for (int i = 0; i < 16; ++i) mx = fmaxf(mx, st[ksub][i]);
    mx = fmaxf(mx, shx(mx, 32));
    const bool raise = (mx - mrun) > 8.0f;
    const float mnew = raise ? mx : mrun;
    const float alpha = raise ? fexp2(mrun - mnew) : 1.0f;
    mrun = mnew;
    float ls = 0.f;
#pragma unroll
    for (int ksub = 0; ksub < 2; ++ksub)
#pragma unroll
        for (int i = 0; i < 16; ++i) { const float p = fexp2(st[ksub][i] - mnew); st[ksub][i] = p; ls += p; }
    lrun = lrun * alpha + ls;
    if (__builtin_amdgcn_ballot_w64(alpha != 1.0f) != 0ull) {
#pragma unroll
        for (int v = 0; v < 4; ++v)
#pragma unroll
            for (int i = 0; i < 16; ++i) ot[v][i] *= alpha;
    }
#pragma unroll
    for (int ksub = 0; ksub < 2; ++ksub)
#pragma unroll
        for (int s = 0; s < 2; ++s)
            pf[ksub][s] = pack8(st[ksub][8 * s], st[ksub][8 * s + 1], st[ksub][8 * s + 2], st[ksub][8 * s + 3], st[ksub][8 * s + 4], st[ksub][8 * s + 5], st[ksub][8 * s + 6], st[ksub][8 * s + 7]);
}
DI void attn_PV(f32x16 (&ot)[4], const bf16x8 (&pf)[2][2], const AttnCtx& c, int vc) {
    const unsigned vb = c.lds0 + AV_BASE + vc * AV_BUF + c.vlane;
    attn_pv2<0>(ot[0], ot[1], vb, pf); attn_pv2<2>(ot[2], ot[3], vb, pf);
}
DI void attn_item(const bf16_t* __restrict__ P, bf16_t* __restrict__ OA, const float* __restrict__ subg, float lam, float one_m_li,
                  int b, int hd, int qb, unsigned char* smem) {
    const int tid = opaque_tid(), wid = __builtin_amdgcn_readfirstlane(tid >> 6), lane = tid & 63, r = lane & 31, h = lane >> 5;
    const int mp = wid >> 2, qs = wid & 3;
    const bf16_t* Pb = P + (size_t)b * LP * PLD;
    const int qrow = qb * 128 + qs * 32 + r;
    bf16x8 bq[4];
#pragma unroll
    for (int ks = 0; ks < 4; ++ks) bq[ks] = *(const bf16x8*)(Pb + (size_t)qrow * PLD + C_AQ + hd * 128 + mp * 64 + ks * 16 + h * 8);
    f32x16 ot[4];
#pragma unroll
    for (int v = 0; v < 4; ++v)
#pragma unroll
        for (int i = 0; i < 16; ++i) ot[v][i] = 0.f;
    float mrun = -INFINITY, lrun = 0.f;
    const int kt0 = (qb >= 1) ? 1 : 0, kt1 = 2 * (qb + 1);
    u32x4 pk[2], pv[2];
    const int srow = tid >> 4, sc16 = tid & 15;
    const bf16_t* gsrc = Pb + (size_t)srow * PLD + hd * 128 + sc16 * 8;
#define A_GLOAD(kt) do { _Pragma("unroll") for (int _i = 0; _i < 2; ++_i) { const bf16_t* _s = gsrc + (size_t)((kt) * 64 + 32 * _i) * PLD; \
        pk[_i] = *(const u32x4*)(_s + C_AK); pv[_i] = *(const u32x4*)(_s + C_AV); } } while (0)
#define A_LSTORE(kbuf, vbuf, ktile) do { _Pragma("unroll") for (int _i = 0; _i < 2; ++_i) { \
        if ((ktile) < 2 && (ktile) * 64 + 32 * _i + srow < PADR) { pk[_i] = (u32x4){0u, 0u, 0u, 0u}; pv[_i] = (u32x4){0u, 0u, 0u, 0u}; }     \
        *(u32x4*)(smem + (kbuf) * AK_BUF + (srow + 32 * _i) * AK_STR + sc16 * 16) = pk[_i]; \
        *(u32x4*)(smem + AV_BASE + (vbuf) * AV_BUF + (srow + 32 * _i) * AV_STR + sc16 * 16) = pv[_i]; } } while (0)
    A_GLOAD(kt0); A_LSTORE(0, 0, kt0);
    __syncthreads();
    AttnCtx c; c.r = r; c.h = h; c.mp = mp; c.qb = qb; c.qrow = qrow; c.smem = smem; c.lds0 = (unsigned)(size_t)smem;
    c.vlane = (unsigned)((4 * h + ((lane >> 2) & 3)) * AV_STR + (16 * ((lane >> 4) & 1) + 4 * (lane & 3)) * 2);
    f32x16 st[2];
    bf16x8 pf[2][2];
    int kc = 0, vc = 0, vp = 2;
    if (mp == 0) {
        for (int kt = kt0; kt < kt1; ++kt) {
            const int vn = (vc == 2) ? 0 : vc + 1;
            if (kt + 1 < kt1) A_GLOAD(kt + 1);
            attn_S(st, bq, c, kc); attn_softmax(st, pf, ot, mrun, lrun, c, kt); attn_PV(ot, pf, c, vc);
            if (kt + 1 < kt1) A_LSTORE(kc ^ 1, vn, kt + 1);
            __syncthreads();
            kc ^= 1; vp = vc; vc = vn;
        }
    } else {
        for (int kt = kt0; kt < kt1; ++kt) {
            const int vn = (vc == 2) ? 0 : vc + 1;
            if (kt + 1 < kt1) A_GLOAD(kt + 1);
            if (kt > kt0) attn_PV(ot, pf, c, vp);
            attn_S(st, bq, c, kc); attn_softmax(st, pf, ot, mrun, lrun, c, kt);
            if (kt + 1 < kt1) A_LSTORE(kc ^ 1, vn, kt + 1);
            __syncthreads();
            kc ^= 1; vp = vc; vc = vn;
        }
        attn_PV(ot, pf, c, vp);
    }
#undef A_GLOAD
#undef A_LSTORE
    const float ltot = lrun + shx(lrun, 32);
    const float inv = 1.0f / ltot;
    float* X = (float*)smem;
    __syncthreads();
    if (mp == 1) {
#pragma unroll
        for (int v = 0; v < 4; ++v)
#pragma unroll
            for (int i = 0; i < 16; ++i) X[(qs * 64 + v * 16 + i) * 64 + lane] = ot[v][i] * inv;
    }
    __syncthreads();
    if (mp == 0) {
        float ss = 0.f;
#pragma unroll
        for (int v = 0; v < 4; ++v)
#pragma unroll
            for (int i = 0; i < 16; ++i) { const float o = ot[v][i] * inv - lam * X[(qs * 64 + v * 16 + i) * 64 + lane]; ot[v][i] = o; ss += o * o; }
        ss += shx(ss, 32);
        const float rs = rsqrtf(ss * (1.0f / 128.0f) + EPS) * one_m_li;
        bf16_t* orow = OA + (size_t)(b * LP + qrow) * (2 * D) + hd * 128;
#pragma unroll
        for (int v = 0; v < 4; ++v)
#pragma unroll
            for (int g4 = 0; g4 < 4; ++g4) {
                const int vc2 = 32 * v + 8 * g4 + 4 * h;
                const f32x4 gv = *(const f32x4*)(subg + vc2);
                u32x2 w; w.x = pk2(ot[v][4 * g4] * rs * gv[0], ot[v][4 * g4 + 1] * rs * gv[1]); w.y = pk2(ot[v][4 * g4 + 2] * rs * gv[2], ot[v][4 * g4 + 3] * rs * gv[3]);
                *(u32x2*)(orow + vc2) = w;
            }
    }
    __syncthreads();
}

constexpr int RV_STR = 576, RV_BYTES = 128 * RV_STR, RKA_STR = 320, RKC_STR = 272;
DI void ret_stage_v(const bf16_t* __restrict__ Pb, int c, int h8, unsigned char* smem) {
    const int tid = opaque_tid();
#pragma unroll
    for (int i = 0; i < 8; ++i) { const int p = tid + 512 * i, row = p >> 5, c16 = p & 31;
        u32x4 w = {0u, 0u, 0u, 0u};
        if (c > 0 || row >= PADR) w = *(const u32x4*)(Pb + (size_t)(c * 128 + row) * PLD + C_RV + h8 * 256 + c16 * 8);
        *(u32x4*)(smem + row * RV_STR + c16 * 16) = w; }
}
template <int S> DI void reta_step(f32x16 (&acc)[4], unsigned va0, unsigned ka0) {
    const unsigned va = va0 + (unsigned)(16 * S * RV_STR), ka = ka0 + (unsigned)(16 * S * RKA_STR);
    const s16x4 al = tr_read<0>(va), ah = tr_read<4 * RV_STR>(va);
    const s16x4 b0l = tr_read<0>(ka), b0h = tr_read<4 * RKA_STR + 0>(ka);
    const s16x4 b1l = tr_read<64>(ka), b1h = tr_read<4 * RKA_STR + 64>(ka);
    const s16x4 b2l = tr_read<128>(ka), b2h = tr_read<4 * RKA_STR + 128>(ka);
    const s16x4 b3l = tr_read<192>(ka), b3h = tr_read<4 * RKA_STR + 192>(ka);
    LGKM0();
    const bf16x8 a = PK8(al, ah);
    acc[0] = MFMA32(a, PK8(b0l, b0h), acc[0]);
    acc[1] = MFMA32(a, PK8(b1l, b1h), acc[1]);
    acc[2] = MFMA32(a, PK8(b2l, b2h), acc[2]);
    acc[3] = MFMA32(a, PK8(b3l, b3h), acc[3]);
}
DI void reta_item(const bf16_t* __restrict__ P, float* __restrict__ KVT, int b, int h8, int c, unsigned char* smem) {
    const int tid = opaque_tid(), wid = __builtin_amdgcn_readfirstlane(tid >> 6), lane = tid & 63, r = lane & 31, h = lane >> 5;
    const bf16_t* Pb = P + (size_t)b * LP * PLD;
    const float lg2 = __log2f(1.0f - fexp2(-5.0f - (float)h8));
    ret_stage_v(Pb, c, h8, smem);
#pragma unroll
    for (int i = 0; i < 4; ++i) { const int p = tid + 512 * i, row = p >> 4, c16 = p & 15;
        u32x4 w = {0u, 0u, 0u, 0u};
        if (c > 0 || row >= PADR) w = *(const u32x4*)(Pb + (size_t)(c * 128 + row) * PLD + C_RK + h8 * 128 + c16 * 8);
        const float d = fexp2(lg2 * (float)(127 - row));
        u32x4 o;
        o.x = pk2(bf2f(w.x & 0xffffu) * d, bf2f(w.x >> 16) * d); o.y = pk2(bf2f(w.y & 0xffffu) * d, bf2f(w.y >> 16) * d);
        o.z = pk2(bf2f(w.z & 0xffffu) * d, bf2f(w.z >> 16) * d); o.w = pk2(bf2f(w.w & 0xffffu) * d, bf2f(w.w >> 16) * d);
        *(u32x4*)(smem + RV_BYTES + row * RKA_STR + c16 * 16) = o; }
    __syncthreads();
    f32x16 acc[4];
#pragma unroll
    for (int t = 0; t < 4; ++t)
#pragma unroll
        for (int i = 0; i < 16; ++i) acc[t][i] = 0.f;
    const unsigned lds0 = (unsigned)(size_t)smem;
    const int qq = (lane >> 2) & 3, pp = lane & 3, blk = (lane >> 4) & 1;
    const unsigned va = lds0 + (unsigned)((8 * h + qq) * RV_STR + (32 * wid + 16 * blk + 4 * pp) * 2);
    const unsigned ka = lds0 + RV_BYTES + (unsigned)((8 * h + qq) * RKA_STR + (16 * blk + 4 * pp) * 2);
    reta_step<0>(acc, va, ka); reta_step<1>(acc, va, ka); reta_step<2>(acc, va, ka); reta_step<3>(acc, va, ka);
    reta_step<4>(acc, va, ka); reta_step<5>(acc, va, ka); reta_step<6>(acc, va, ka); reta_step<7>(acc, va, ka);
    __syncthreads();
    float* Lw = (float*)smem + wid * 4096;
#pragma unroll
    for (int t = 0; t < 4; ++t)
#pragma unroll
        for (int i = 0; i < 16; ++i) Lw[crow(i, h) * 128 + 32 * t + r] = acc[t][i];
    asm volatile("s_waitcnt lgkmcnt(0)" ::: "memory");
    float* dst = KVT + ((size_t)((b * 8 + h8) * 16 + c)) * 32768 + (size_t)(32 * wid) * 128;
    const int orow = lane >> 5, ocol = (lane & 31) * 4;
#pragma unroll
    for (int j = 0; j < 16; ++j) st16_wt(dst + (2 * j + orow) * 128 + ocol, *(const f32x4*)(Lw + (2 * j + orow) * 128 + ocol));
    __syncthreads();
}
template <int VT> DI void retc_pv(f32x16& o, unsigned vb, const bf16x8 (&pf)[2]) {
    const s16x4 l0 = tr_read<(0) * RV_STR + VT * 64>(vb), h0 = tr_read<(8) * RV_STR + VT * 64>(vb);
    const s16x4 l1 = tr_read<(16) * RV_STR + VT * 64>(vb), h1 = tr_read<(24) * RV_STR + VT * 64>(vb);
    LGKM0();
    o = MFMA32(PK8(l0, h0), pf[0], o);
    o = MFMA32(PK8(l1, h1), pf[1], o);
}
DI void retc_item(const bf16_t* __restrict__ P, const bf16_t* __restrict__ PREVT, bf16_t* __restrict__ OR_, const float* __restrict__ gng,
                  int b, int h8, int c, unsigned char* smem) {
    const int tid = opaque_tid(), wid = __builtin_amdgcn_readfirstlane(tid >> 6), lane = tid & 63, r = lane & 31, h = lane >> 5;
    const int nb = wid & 3, dh = wid >> 2;
    const bf16_t* Pb = P + (size_t)b * LP * PLD;
    const float lg2 = __log2f(1.0f - fexp2(-5.0f - (float)h8));
    u32x4 rv[8], rk[4];
#pragma unroll
    for (int i = 0; i < 8; ++i) { const int p = tid + 512 * i, row = p >> 5, c16 = p & 31;
        rv[i] = (u32x4){0u, 0u, 0u, 0u};
        if (c > 0 || row >= PADR) rv[i] = *(const u32x4*)(Pb + (size_t)(c * 128 + row) * PLD + C_RV + h8 * 256 + c16 * 8); }
#pragma unroll
    for (int i = 0; i < 4; ++i) { const int p = tid + 512 * i, row = p >> 4, c16 = p & 15;
        rk[i] = (u32x4){0u, 0u, 0u, 0u};
        if (c > 0 || row >= PADR) rk[i] = *(const u32x4*)(Pb + (size_t)(c * 128 + row) * PLD + C_RK + h8 * 128 + c16 * 8); }
    const int nloc = 32 * nb + r;
    const int grow = b * LP + c * 128 + nloc;
    bf16x8 bq[8];
#pragma unroll
    for (int ks = 0; ks < 8; ++ks) bq[ks] = *(const bf16x8*)(P + (size_t)grow * PLD + C_RQ + h8 * 128 + ks * 16 + h * 8);
    f32x16 acc[4];
    const bf16_t* pv = PREVT + ((size_t)((b * 8 + h8) * 17 + c)) * 32768 + (size_t)(128 * dh + r) * 128 + h * 8;
    bf16x8 pa[2][8];
#pragma unroll
    for (int ks = 0; ks < 8; ++ks) pa[0][ks] = *(const bf16x8*)(pv + ks * 16);
#pragma unroll
    for (int v = 0; v < 4; ++v) {
        if (v + 1 < 4) {
#pragma unroll
            for (int ks = 0; ks < 8; ++ks) pa[(v + 1) & 1][ks] = *(const bf16x8*)(pv + (size_t)(32 * (v + 1)) * 128 + ks * 16);
        }
#pragma unroll
        for (int i = 0; i < 16; ++i) acc[v][i] = 0.f;
#pragma unroll
        for (int ks = 0; ks < 8; ++ks) acc[v] = MFMA32(pa[v & 1][ks], bq[ks], acc[v]);
    }
#pragma unroll
    for (int i = 0; i < 8; ++i) { const int p = tid + 512 * i, row = p >> 5, c16 = p & 31; *(u32x4*)(smem + row * RV_STR + c16 * 16) = rv[i]; }
#pragma unroll
    for (int i = 0; i < 4; ++i) { const int p = tid + 512 * i, row = p >> 4, c16 = p & 15; *(u32x4*)(smem + RV_BYTES + row * RKC_STR + c16 * 16) = rk[i]; }
    __syncthreads();
    const float dq = fexp2(lg2 * (float)(nloc + 1));
#pragma unroll
    for (int v = 0; v < 4; ++v)
#pragma unroll
        for (int i = 0; i < 16; ++i) acc[v][i] *= dq;
    const unsigned lds0 = (unsigned)(size_t)smem;
    const int qq = (lane >> 2) & 3, pp = lane & 3, blk = (lane >> 4) & 1;
    for (int mt = 0; mt <= nb; ++mt) {
        f32x16 st;
#pragma unroll
        for (int i = 0; i < 16; ++i) st[i] = 0.f;
#pragma unroll
        for (int ks = 0; ks < 8; ++ks) {
            const bf16x8 a = *(const bf16x8*)(smem + RV_BYTES + (32 * mt + r) * RKC_STR + (ks * 16 + h * 8) * 2);
            st = MFMA32(a, bq[ks], st);
        }
#pragma unroll
        for (int i = 0; i < 16; ++i) { const int dd = nloc - (32 * mt + crow(i, h)); st[i] = (dd >= 0) ? st[i] * fexp2(lg2 * (float)dd) : 0.f; }
        bf16x8 pf[2];
        pf[0] = pack8(st[0], st[1], st[2], st[3], st[4], st[5], st[6], st[7]);
        pf[1] = pack8(st[8], st[9], st[10], st[11], st[12], st[13], st[14], st[15]);
        const unsigned vb = lds0 + (unsigned)((32 * mt + 4 * h + qq) * RV_STR + (128 * dh + 16 * blk + 4 * pp) * 2);
        retc_pv<0>(acc[0], vb, pf); retc_pv<1>(acc[1], vb, pf); retc_pv<2>(acc[2], vb, pf); retc_pv<3>(acc[3], vb, pf);
    }
    float s1 = 0.f, s2 = 0.f;
#pragma unroll
    for (int v = 0; v < 4; ++v)
#pragma unroll
        for (int i = 0; i < 16; ++i) { s1 += acc[v][i]; s2 += acc[v][i] * acc[v][i]; }
    s1 += shx(s1, 32); s2 += shx(s2, 32);
    float* ST = (float*)(smem + RV_BYTES + 128 * RKC_STR);
    if (h == 0) { ST[(dh * 128 + nloc) * 2] = s1; ST[(dh * 128 + nloc) * 2 + 1] = s2; }
    __syncthreads();
    const float t1 = ST[nloc * 2] + ST[(128 + nloc) * 2], t2 = ST[nloc * 2 + 1] + ST[(128 + nloc) * 2 + 1];
    const float mu = t1 * (1.0f / 256.0f);
    const float var = fmaxf(t2 * (1.0f / 256.0f) - mu * mu, 0.f);
    const float rstd = rsqrtf(var + EPS);
#pragma unroll
    for (int v = 0; v < 4; ++v)
#pragma unroll
        for (int g4 = 0; g4 < 4; ++g4) {
            const int col = h8 * 256 + 128 * dh + 32 * v + 8 * g4 + 4 * h;
            const f32x4 gv = *(const f32x4*)(gng + col);
            const u32x2 sw = *(const u32x2*)(P + (size_t)grow * PLD + C_RG + col);
            const float y0 = (acc[v][4 * g4] - mu) * rstd * gv[0] * bf2f(sw.x & 0xffffu);
            const float y1 = (acc[v][4 * g4 + 1] - mu) * rstd * gv[1] * bf2f(sw.x >> 16);
            const float y2 = (acc[v][4 * g4 + 2] - mu) * rstd * gv[2] * bf2f(sw.y & 0xffffu);
            const float y3 = (acc[v][4 * g4 + 3] - mu) * rstd * gv[3] * bf2f(sw.y >> 16);
            u32x2 w; w.x = pk2(y0, y1); w.y = pk2(y2, y3);
            *(u32x2*)(OR_ + (size_t)grow * (2 * D) + col) = w;
        }
    __syncthreads();
}

__global__ void __launch_bounds__(512, 2) fwd_megakernel(Params prm) {
    extern __shared__ __attribute__((aligned(16))) unsigned char smem[];
    cg::grid_group grid = cg::this_grid();
    unsigned epoch = 0;
    unsigned char* ws = prm.ws;
#define WSP(T, OFF) ((T*)(wsl(ws) + (OFF)))
#define BAR WSP(unsigned, WS_BAR)
#define GSYNC() do { ++epoch; fast_barrier(BAR, epoch); } while (0)
    const int tid = threadIdx.x, wid = tid >> 6, lane = tid & 63;
#define LAM WSP(float, WS_LAM)
#define TA WSP(float, WS_TA)
#define TR WSP(float, WS_TR)
#define HF WSP(float, WS_HF)
#define HB WSP(bf16_t, WS_HB)
#define P WSP(bf16_t, WS_P)
#define U WSP(bf16_t, WS_P)
#define OA WSP(bf16_t, WS_OA)
#define OR_ (WSP(bf16_t, WS_OA) + D)
#define MG WSP(bf16_t, WS_MG)
#define PREVT WSP(bf16_t, WS_MG)
#define ACT WSP(bf16_t, WS_ACT)
#define KVT WSP(float, WS_ACT)
    LAS unsigned char* lds = (LAS unsigned char*)smem;
    const int gw = blockIdx.x * 8 + wid, nw = gridDim.x * 8;

    transpose_convert<true>(prm.in[4], (bf16_t*)(ws + WS_WIN), D, WIN);
    for (int i = blockIdx.x * 512 + tid; i < LP * 96; i += gridDim.x * 512) {
        const int l = i / 96, j = i % 96; const float pos = (float)(l - PADR);
        float f; float* dst;
        if (j < 32) { f = 1.0f / powf(10000.0f, (float)(2 * j) / 64.0f); dst = TA + ((size_t)l * 32 + j) * 2; }
        else { const int jj = j - 32; f = 1.0f / powf(10000.0f, (float)jj / 63.0f); dst = TR + ((size_t)l * 64 + jj) * 2; }
        const float ang = pos * f;
        dst[0] = (float)cos((double)ang); dst[1] = (float)sin((double)ang);
    }
    if (tid < 23) ((const float**)(ws + WS_TAB))[tid] = (tid < 22) ? prm.in[tid] : (const float*)prm.out;
    if (blockIdx.x == 0 && tid < 2) {
        const int l = tid; float s1 = 0.f, s2 = 0.f;
        for (int i = 0; i < 64; ++i) { s1 += prm.in[5][l * 64 + i] * prm.in[6][l * 64 + i]; s2 += prm.in[7][l * 64 + i] * prm.in[8][l * 64 + i]; }
        const float li = 0.8f - 0.6f * expf(-0.3f * (float)l);
        LAM[l] = expf(s1) - expf(s2) + li;
    }
    for (int row = gw; row < MROWS; row += nw) {
        const int b = row / LP, l = row % LP;
        if (l < PADR) continue;
        f32x4 x[8];
        {
            const float* src = (l < 128) ? prm.in[1] + (size_t)(l - PADR) * D : prm.in[0] + ((size_t)b * SEQ + (l - 128)) * D;
#pragma unroll
            for (int j = 0; j < 8; ++j) x[j] = *(const f32x4*)(src + (j * 64 + lane) * 4);
        }
        ln_row(x, prm.in[2], prm.in[3], lane);
        store_h(x, HF, HB, row, lane);
    }
    grid.sync();

#pragma nounroll
    for (int layer = 0; layer < 2; ++layer) {
        const float lam_init = 0.8f - 0.6f * expf(-0.3f * (float)layer);
        for (int rep = 0; rep < REP_INPROJ; ++rep)
        {
            pg8::Gemm g{HB, (const bf16_t*)(ws + WS_WIN + layer * SZ_WIN), MROWS, WIN, D};
            pg8::StaticOrder S; S.init(NB * SEQ, WIN, gridDim.x, blockIdx.x);
            EpiIn E{P, TA, TR};
            pg8::gemm_phase(lds, g, S, E);
            meta_gemm(g.A, g.Bt, WIN, D, E, smem);
        }
        GSYNC();
        for (int rep = 0; rep < REP_ATTN; ++rep)
        {
            const float lam = LAM[layer];
            volatile int* sidx = (volatile int*)(smem + LDS_MISC);
            const int qt = opaque_tid();
            const int grp = blockIdx.x & 7;
            unsigned* qbase = (unsigned*)(ws + WS_QCTR);
            unsigned* qctr = qbase + 16 * (layer * 8 + grp) + 256 * rep;
            unsigned* pa_done = qbase + 512 + layer * 32;
            unsigned* sc_done = qbase + 576 + layer * 32;
            for (;;) {
                if (qt == 0) *sidx = (int)atomicAdd(qctr, 1u);
                __syncthreads();
                const int idx = __builtin_amdgcn_readfirstlane(*sidx);
                __syncthreads();
                const int NC = (layer == 0) ? ((CT_ITEMS - grp + 7) >> 3) : 0;
                if (idx >= 300 + NC) break;
                if (idx < 64) {
                    const int bh = grp + 8 * (idx >> 4), c = idx & 15;
                    reta_item(P, KVT, bh >> 3, bh & 7, c, smem);
                    item_signal_wt(pa_done + bh);
                } else if (idx < 96) {
                    const int j = idx - 64, bh = grp + 8 * (j >> 3), part = j & 7, h8 = bh & 7;
                    item_wait(pa_done + bh, 16u);
                    const int off = part * 4096 + qt * 8;
                    const float cd = fexp2(128.0f * __log2f(1.0f - fexp2(-5.0f - (float)h8)));
                    float sst[8]; float zz = 0.f; asm volatile("" : "+v"(zz));
#pragma unroll
                    for (int e = 0; e < 8; ++e) sst[e] = zz;
                    f32x4 kk[16][2];
#pragma unroll
                    for (int c = 0; c < 16; ++c) {
                        const float* kp = KVT + ((size_t)(bh * 16 + c)) * 32768 + off;
                        kk[c][0] = *(const f32x4*)kp; kk[c][1] = *(const f32x4*)(kp + 4);
                    }
#pragma unroll
                    for (int c = 0; c < 17; ++c) {
                        u32x4 w; w.x = pk2(sst[0], sst[1]); w.y = pk2(sst[2], sst[3]); w.z = pk2(sst[4], sst[5]); w.w = pk2(sst[6], sst[7]);
                        st16_wt(PREVT + ((size_t)(bh * 17 + c)) * 32768 + off, w);
                        if (c < 16) {
#pragma unroll
                            for (int e = 0; e < 4; ++e) { sst[e] = cd * sst[e] + kk[c][0][e]; sst[4 + e] = cd * sst[4 + e] + kk[c][1][e]; }
                        }
                    }
                    item_signal_wt(sc_done + bh);
                } else if (idx < 232 + NC) {
                    const int p = idx - 96;
                    int ai = -1, ci = -1;
                    if (p < 3 * NC) { if (p % 3 == 2) ci = p / 3; else ai = p - p / 3; } else ai = p - NC;
                    if (ai >= 136) { ci = NC - 1 - (ai - 136); ai = -1; }
                    if (ci >= 0) {
                        const int item = grp + 8 * ci;
                        convert_deferred_item(ws, item);
                    } else {
                        const int bh = grp + 8 * (ai / 17), qb = 16 - (ai % 17);
                        attn_item(P, OA, argp(ws, 9) + layer * 128, lam, 1.0f - lam_init, bh >> 4, bh & 15, qb, smem);
                    }
                } else {
                    const int j = idx - 232 - NC; const int bh = grp + 8 * (j / 17), c = j % 17;
                    item_wait(sc_done + bh, 8u);
                    retc_item(P, PREVT, OR_, argp(ws, 10) + layer * D, bh >> 3, bh & 7, c, smem);
                }
            }
        }
        GSYNC();
        {
            pg8::StaticOrder S; S.init(NB * SEQ, D, gridDim.x, blockIdx.x);
            pg8::Gemm g{OA, (const bf16_t*)(ws + WS_WA + layer * 2 * SZ_SQ), MROWS, D, 2 * D};
            EpiMerge E{P, MG};
            pg8::gemm_phase(lds, g, S, E);
            meta_gemm_merge(g.A, g.Bt, E, smem);
        }
        GSYNC();
        {
            pg8::StaticOrder S; S.init(NB * SEQ, D, gridDim.x, blockIdx.x);
            pg8::Gemm g{MG, (const bf16_t*)(ws + WS_WO + layer * SZ_SQ), MROWS, D, D};
            EpiLN E{HF, HB, nullptr, argp(ws, 14) + layer * D, argp(ws, 15) + layer * D, (float*)(ws + WS_STATS), (unsigned*)(ws + WS_LNCNT) + (layer * 2 + 0) * 64, smem};
            pg8::gemm_phase(lds, g, S, E);
            meta_gemm_ln(g.A, g.Bt, D, E, smem);
        }
        GSYNC();
        {
            pg8::StaticOrder S; S.init(NB * SEQ, DFF2, gridDim.x, blockIdx.x);
            pg8::Gemm g{HB, (const bf16_t*)(ws + WS_WUP + layer * SZ_WUP), MROWS, DFF2, D};
            EpiUp E{U};
            pg8::gemm_phase(lds, g, S, E);
            meta_gemm(g.A, g.Bt, DFF2, D, E, smem);
        }
        GSYNC();
        for (int rep = 0; rep < REP_MISC; ++rep)
        {
            const float* cw = argp(ws, 17) + (size_t)layer * 3 * DFF2; const float* cb = argp(ws, 18) + (size_t)layer * DFF2;
            const int ctid = opaque_tid();
            for (int idx = blockIdx.x * 512 + ctid; idx < NB * 129 * (DFF / 8); idx += gridDim.x * 512) {
                const int rbi = idx / (DFF / 8), j = (idx % (DFF / 8)) * 8;
                const int b = rbi / 129, l0 = PADR + (rbi % 129) * 16;
                const bf16_t* up = U + (size_t)(b * LP + l0) * DFF2 + j;
                float w[2][3][8], bs[2][8];
#pragma unroll
                for (int q = 0; q < 2; ++q) {
#pragma unroll
                    for (int t = 0; t < 3; ++t) { const f32x4 a0 = *(const f32x4*)(cw + (size_t)t * DFF2 + q * DFF + j), a1 = *(const f32x4*)(cw + (size_t)t * DFF2 + q * DFF + j + 4);
#pragma unroll
                        for (int e = 0; e < 4; ++e) { w[q][t][e] = a0[e]; w[q][t][4 + e] = a1[e]; } }
                    const f32x4 c0 = *(const f32x4*)(cb + q * DFF + j), c1 = *(const f32x4*)(cb + q * DFF + j + 4);
#pragma unroll
                    for (int e = 0; e < 4; ++e) { bs[q][e] = c0[e]; bs[q][4 + e] = c1[e]; }
                }
                u32x4 h2[2], h1[2];
#pragma unroll
                for (int q = 0; q < 2; ++q) {
                    h2[q] = (u32x4){0u, 0u, 0u, 0u}; h1[q] = (u32x4){0u, 0u, 0u, 0u};
                    if (l0 > PADR) { h2[q] = *(const u32x4*)(up - 2 * (size_t)DFF2 + q * DFF); h1[q] = *(const u32x4*)(up - (size_t)DFF2 + q * DFF); }
                }
#pragma unroll 4
                for (int t = 0; t < 16; ++t) {
                    u32x4 h0[2];
#pragma unroll
                    for (int q = 0; q < 2; ++q) h0[q] = *(const u32x4*)(up + (size_t)t * DFF2 + q * DFF);
                    float c[2][8];
#pragma unroll
                    for (int q = 0; q < 2; ++q) {
#pragma unroll
                        for (int e2 = 0; e2 < 4; ++e2) {
                            const unsigned x2 = h2[q][e2], x1 = h1[q][e2], x0 = h0[q][e2];
                            c[q][2 * e2] = bs[q][2 * e2] + w[q][0][2 * e2] * bf2f(x2 & 0xffffu) + w[q][1][2 * e2] * bf2f(x1 & 0xffffu) + w[q][2][2 * e2] * bf2f(x0 & 0xffffu);
                            c[q][2 * e2 + 1] = bs[q][2 * e2 + 1] + w[q][0][2 * e2 + 1] * bf2f(x2 >> 16) + w[q][1][2 * e2 + 1] * bf2f(x1 >> 16) + w[q][2][2 * e2 + 1] * bf2f(x0 >> 16);
                        }
                        h2[q] = h1[q]; h1[q] = h0[q];
                    }
                    float a[8];
#pragma unroll
                    for (int e = 0; e < 8; e += 2) { const f32x2 gg = gelu_pk((f32x2){c[0][e], c[0][e + 1]}); a[e] = gg.x * c[1][e]; a[e + 1] = gg.y * c[1][e + 1]; }
                    u32x4 o; o.x = pk2(a[0], a[1]); o.y = pk2(a[2], a[3]); o.z = pk2(a[4], a[5]); o.w = pk2(a[6], a[7]);
                    *(u32x4*)(ACT + (size_t)(b * LP + l0 + t) * DFF + j) = o;
                }
            }
        }
        GSYNC();
        {
            pg8::StaticOrder S; S.init(NB * SEQ, D, gridDim.x, blockIdx.x);
            pg8::Gemm g{ACT, (const bf16_t*)(ws + WS_WDN + layer * SZ_WDN), MROWS, D, DFF};
            EpiLN E{HF, HB, (layer == 1) ? (float*)argp(ws, 22) : nullptr, argp(ws, 20) + layer * D, argp(ws, 21) + layer * D, (float*)(ws + WS_STATS), (unsigned*)(ws + WS_LNCNT) + (layer * 2 + 1) * 64, smem};
            pg8::gemm_phase(lds, g, S, E);
            if (layer == 0) meta_gemm_ln(g.A, g.Bt, DFF, E, smem);
        }
        if (layer == 0) GSYNC();
    }
}

extern "C" void kernel_launch(void* const* d_in, const int* in_sizes, int n_in, void* d_out, int out_size, void* d_ws, size_t ws_size, hipStream_t stream) {
    static int grid_blocks = 0;
    if (!grid_blocks) {
        if (n_in != 22 || ws_size < WS_END) { fprintf(stderr, "kernel_launch: unexpected n_in %d or ws %zu < %zu\n", n_in, ws_size, (size_t)WS_END); grid_blocks = -1; return; }
        int dev = 0, cus = 0, per_cu = 0;
        hipGetDevice(&dev);
        hipDeviceGetAttribute(&cus, hipDeviceAttributeMultiprocessorCount, dev);
        if (hipFuncSetAttribute((const void*)fwd_megakernel, hipFuncAttributeMaxDynamicSharedMemorySize, LDS_BYTES) != hipSuccess) fprintf(stderr, "kernel_launch: hipFuncSetAttribute failed\n");
        if (hipOccupancyMaxActiveBlocksPerMultiprocessor(&per_cu, (const void*)fwd_megakernel, 512, LDS_BYTES) != hipSuccess || per_cu < 1) { fprintf(stderr, "kernel_launch: occupancy query gave %d\n", per_cu); per_cu = 1; }
        (void)hipGetLastError();
        grid_blocks = cus * (per_cu > 1 ? 1 : per_cu);
        if (grid_blocks > 256) grid_blocks = 256;
        if (grid_blocks != 256) { fprintf(stderr, "kernel_launch: this kernel needs exactly 256 resident workgroups (got %d); nothing launched\n", grid_blocks); grid_blocks = -1; return; }
    }
    if (grid_blocks < 0) return;
    (void)hipMemsetAsync((char*)d_ws + WS_CTR, 0, WS_TA, stream);
    Params p{};
    for (int i = 0; i < 22; ++i) p.in[i] = (const float*)d_in[i];
    p.out = (float*)d_out; p.ws = (unsigned char*)d_ws;
    void* args[] = {&p};
    hipError_t e = hipLaunchCooperativeKernel((const void*)fwd_megakernel, dim3(grid_blocks), dim3(512), args, LDS_BYTES, stream);
    if (e != hipSuccess) fprintf(stderr, "cooperative launch failed: %s (grid %d)\n", hipGetErrorString(e), grid_blocks);
}
```

```cpp
#include <hip/hip_runtime.h>
#include <hip/hip_cooperative_groups.h>
#include <cstdio>
namespace cg = cooperative_groups;

#define LAS __attribute__((address_space(3)))
#define DI __device__ __forceinline__
typedef unsigned short bf16_t;
typedef short bf16x8 __attribute__((ext_vector_type(8)));
typedef short s16x4 __attribute__((ext_vector_type(4)));
typedef float f32x2 __attribute__((ext_vector_type(2)));
typedef float f32x4 __attribute__((ext_vector_type(4)));
typedef float f32x16 __attribute__((ext_vector_type(16)));
typedef unsigned u32x2 __attribute__((ext_vector_type(2)));
typedef unsigned u32x4 __attribute__((ext_vector_type(4)));
typedef __bf16 bf2_t __attribute__((ext_vector_type(2)));

constexpr int D = 2048, NB = 4, LP = 2176, MROWS = NB * LP, PADR = 112, SEQ = 2048;
constexpr int WIN = 16384, DFF = 5504, DFF2 = 11008;
constexpr int PLD = WIN + 128;
constexpr float ALPHA = 1.41421356237f, EPS = 1e-5f;
constexpr int C_AQ = 0, C_AK = 2048, C_AV = 4096, C_RQ = 6144, C_RK = 7168, C_RV = 8192, C_RG = 10240, C_GA = 12288, C_GB = 14336;

constexpr size_t WS_CTR = 0;
constexpr size_t WS_LAM = 256;
constexpr size_t WS_BAR = 512;
constexpr size_t WS_QCTR = 512 + 5120;
constexpr size_t WS_LNCNT = 512 + 8192;
constexpr size_t WS_TAB = 512 + 8192 + 2048;
constexpr size_t WS_XB = 512 + 16384;
constexpr size_t WS_TA = 512 + 16384 + 16384;
constexpr size_t WS_TR = WS_TA + (size_t)LP * 32 * 2 * 4;
constexpr size_t WS_WIN = WS_TR + (size_t)LP * 64 * 2 * 4;
constexpr size_t SZ_WIN = (size_t)WIN * D * 2;
constexpr size_t WS_WA = WS_WIN + 2 * SZ_WIN;
constexpr size_t SZ_SQ = (size_t)D * D * 2;
constexpr size_t WS_WB = WS_WA + 2 * SZ_SQ;
constexpr size_t WS_WO = WS_WB + 2 * SZ_SQ;
constexpr size_t WS_WUP = WS_WO + 2 * SZ_SQ;
constexpr size_t SZ_WUP = (size_t)DFF2 * D * 2;
constexpr size_t WS_WDN = WS_WUP + 2 * SZ_WUP;
constexpr size_t SZ_WDN = (size_t)D * DFF * 2;
constexpr size_t WS_HF = WS_WDN + 2 * SZ_WDN;
constexpr size_t WS_HB = WS_HF + (size_t)MROWS * D * 4;
constexpr size_t WS_P = WS_HB + (size_t)MROWS * D * 2;
constexpr size_t WS_OA = WS_P + (size_t)MROWS * PLD * 2;
constexpr size_t WS_OR = WS_OA + (size_t)MROWS * D * 2;
constexpr size_t WS_MG = WS_OR + (size_t)MROWS * D * 2;
constexpr size_t WS_PRE = WS_MG + (size_t)MROWS * D * 2;
constexpr size_t WS_ACT = WS_PRE + (size_t)MROWS * D * 4;
constexpr size_t WS_STATS = WS_ACT + (size_t)MROWS * DFF * 2;
constexpr size_t WS_END = WS_STATS + (size_t)(32 * 8 * 256 + 64 * 16) * 8;

#define REP_P0 1
#define REP_INPROJ 1
#define REP_ATTN 1
#define REP_MISC 1
#ifndef PMASK
#define PMASK 0xffff
#endif
constexpr int LDS_BYTES = 131072 + 1024;
constexpr int LDS_MISC = 131072;

struct Params { const float* in[22]; float* out; unsigned char* ws; };

DI int opaque_tid() { int t = threadIdx.x; asm volatile("" : "+v"(t)); return t; }
DI float shx(float v, int mask) { const int l = opaque_tid() & 63; return __int_as_float(__builtin_amdgcn_ds_bpermute((l ^ mask) << 2, __float_as_int(v))); }
DI float bf2f(unsigned h) { return __uint_as_float(h << 16); }
DI unsigned pk2(float lo, float hi) { f32x2 v = {lo, hi}; bf2_t b = __builtin_convertvector(v, bf2_t); return __builtin_bit_cast(unsigned, b); }
DI bf16_t f2bf(float x) { return (bf16_t)(pk2(x, 0.f) & 0xffffu); }
DI float wave_sum(float v) { for (int o = 32; o; o >>= 1) v += shx(v, o); return v; }
DI int crow(int i, int h) { return (i & 3) + 8 * (i >> 2) + 4 * h; }
DI float fexp2(float x) { return __builtin_amdgcn_exp2f(x); }
DI float sigmoidf_(float x) { return __builtin_amdgcn_rcpf(1.0f + fexp2(-1.4426950408889634f * x)); }
#define MFMA32(a, b, c) __builtin_amdgcn_mfma_f32_32x32x16_bf16((a), (b), (c), 0, 0, 0)
template <int OFF> DI s16x4 tr_read(unsigned addr) { s16x4 r; asm volatile("ds_read_b64_tr_b16 %0, %1 offset:%2" : "=&v"(r) : "v"(addr), "i"(OFF) : "memory"); return r; }
#define LGKM0() do { asm volatile("s_waitcnt lgkmcnt(0)" ::: "memory"); __builtin_amdgcn_sched_barrier(0); } while (0)
#define PK8(L, H) (bf16x8){L[0], L[1], L[2], L[3], H[0], H[1], H[2], H[3]}
DI bf16x8 pack8(float a0, float a1, float a2, float a3, float a4, float a5, float a6, float a7) {
    u32x4 w; w.x = pk2(a0, a1); w.y = pk2(a2, a3); w.z = pk2(a4, a5); w.w = pk2(a6, a7); return __builtin_bit_cast(bf16x8, w);
}


DI unsigned ab_ld(unsigned* p) { return __hip_atomic_load(p, __ATOMIC_RELAXED, __HIP_MEMORY_SCOPE_AGENT); }
DI unsigned ab_add(unsigned* p, unsigned v) { return __hip_atomic_fetch_add(p, v, __ATOMIC_RELAXED, __HIP_MEMORY_SCOPE_AGENT); }
#define AB_SPIN(cond) do { unsigned _sp = 0; while (cond) { __builtin_amdgcn_s_sleep(1); if (++_sp > (1u << 24)) break; } } while (0)
DI void fast_barrier(unsigned* bar, unsigned epoch) {
    asm volatile("s_waitcnt vmcnt(0)" ::: "memory");
    __syncthreads();
    if (threadIdx.x == 0) {
        const unsigned G = gridDim.x, g = blockIdx.x & 7u, ng = (G - g + 7u) >> 3, ngroups = G < 8u ? G : 8u;
        __builtin_amdgcn_fence(__ATOMIC_RELEASE, "agent");
        asm volatile("s_waitcnt vmcnt(0)" ::: "memory");
        unsigned* sub = bar + 64 * (1 + g); unsigned* gen = bar + 64 * (9 + g); unsigned* top = bar + 64 * 17; unsigned* topgen = bar + 64 * 18;
        const unsigned old = ab_add(sub, 1u);
        if (old + 1u == epoch * ng) {
            const unsigned ot = ab_add(top, 1u);
            if (ot + 1u == epoch * ngroups) ab_add(topgen, 1u);
            else AB_SPIN(ab_ld(topgen) < epoch);
            ab_add(gen, 1u);
        } else {
            AB_SPIN(ab_ld(gen) < epoch);
        }
        __builtin_amdgcn_fence(__ATOMIC_ACQUIRE, "agent");
        asm volatile("s_waitcnt vmcnt(0)" ::: "memory");
    }
    __syncthreads();
}

#define GAS __attribute__((address_space(1)))
DI unsigned char* wsl(unsigned char* ws) { GAS unsigned char* g = (GAS unsigned char*)ws; asm volatile("" : "+s"(g)); return (unsigned char*)g; }
DI const float* argp(unsigned char* ws, int i) {
    GAS const unsigned long long* t = (GAS const unsigned long long*)(ws + WS_TAB);
    asm volatile("" : "+s"(t));
    GAS const float* p = (GAS const float*)t[i];
    return (const float*)p;
}

DI f32x2 gelu_pk(f32x2 v) {
    const f32x2 av = __builtin_elementwise_abs(v), d = av * 0.2316418882f + 1.0f;
    f32x2 t; t.x = __builtin_amdgcn_rcpf(d.x); t.y = __builtin_amdgcn_rcpf(d.y);
    f32x2 q = t * 0.5307027145f + (-0.7265760135f); q = q * t + 0.7107068705f; q = q * t + (-0.142248368f); q = q * t + 0.127414796f; q = q * t;
    const f32x2 s = (v * v) * (-0.72134752044f);
    f32x2 e; e.x = __builtin_amdgcn_exp2f(s.x); e.y = __builtin_amdgcn_exp2f(s.y);
    const f32x2 m = v * (q * e), r = v - m;
    f32x2 o; o.x = v.x < 0.f ? m.x : r.x; o.y = v.y < 0.f ? m.y : r.y; return o;
}

#define XB_TMO      128
#define XB_XCNT(j)  (256  + 64 * (j))
#define XB_XSUB(j)  (1280 + 64 * (j))
#define XB_XGEN(j)  (2304 + 64 * (j))
#define XB_TOP      3328
#define XB_TOPGEN   3392
#define XB_SPIN_CAP (1u << 22)
DI unsigned xb_xcc_id() { return (unsigned)__builtin_amdgcn_s_getreg((3 << 11) | 20) & 0xFu; }
#define XB_SPIN(cond, bar) do { unsigned _sp = 0; while (cond) { __builtin_amdgcn_s_sleep(1); \
    if ((++_sp & 255u) == 0u) { if (ab_ld(&(bar)[XB_TMO])) break; if (_sp > XB_SPIN_CAP) { atomicAdd(&(bar)[XB_TMO], 1u); break; } } } } while (0)
struct XcdBarrier { unsigned* bar; unsigned x; volatile LAS unsigned* st; };
DI XcdBarrier xcd_barrier_post(unsigned* bar, volatile LAS unsigned* st) {
    XcdBarrier b; b.bar = bar; b.x = xb_xcc_id(); b.st = st;
    if (threadIdx.x == 0) (void)ab_add(&bar[XB_XCNT(b.x)], 1u);
    return b;
}
DI void xcd_barrier_complete(unsigned* bar, unsigned x, unsigned& nloc, unsigned& nx) {
    const unsigned G = gridDim.x;
    unsigned sum, cnt, mine, sp = 0u;
    for (;;) {
        sum = 0u; cnt = 0u; mine = 0u;
#pragma unroll
        for (unsigned j = 0; j < 16; ++j) { const unsigned c = ab_ld(&bar[XB_XCNT(j)]); sum += c; cnt += (c > 0u) ? 1u : 0u; mine = (j == x) ? c : mine; }
        if (sum == G) break;
        __builtin_amdgcn_s_sleep(1);
        if ((++sp & 255u) == 0u) { if (ab_ld(&bar[XB_TMO])) break; if (sp > XB_SPIN_CAP) { atomicAdd(&bar[XB_TMO], 1u); break; } }
    }
    nloc = mine > 0u ? mine : 1u; nx = cnt > 0u ? cnt : 1u;
}
DI void xcd_barrier(const XcdBarrier& b) {
    asm volatile("s_waitcnt vmcnt(0)" ::: "memory");
    __syncthreads();
    if (threadIdx.x == 0) {
        unsigned* bar = b.bar;
        __builtin_amdgcn_s_waitcnt(0);
        unsigned nloc = b.st[0], nx = b.st[1];
        if (nloc == 0u) { xcd_barrier_complete(bar, b.x, nloc, nx); b.st[0] = nloc; b.st[1] = nx; }
        const unsigned old = ab_add(&bar[XB_XSUB(b.x)], 1u);
        const unsigned gen = old / nloc;
        if (old + 1u == (gen + 1u) * nloc) {
            __builtin_amdgcn_fence(__ATOMIC_RELEASE, "agent");
            asm volatile("s_waitcnt vmcnt(0)" ::: "memory");
            const unsigned og = ab_add(&bar[XB_TOP], 1u);
            const unsigned tg = og / nx;
            if (og + 1u == (tg + 1u) * nx) ab_add(&bar[XB_TOPGEN], 1u);
            else XB_SPIN(ab_ld(&bar[XB_TOPGEN]) == tg, bar);
            __builtin_amdgcn_fence(__ATOMIC_ACQUIRE, "agent");
            ab_add(&bar[XB_XGEN(b.x)], 1u);
            asm volatile("s_waitcnt vmcnt(0)" ::: "memory");
        } else {
            XB_SPIN(ab_ld(&bar[XB_XGEN(b.x)]) == gen, bar);
            __builtin_amdgcn_fence(__ATOMIC_ACQUIRE, "agent");
            asm volatile("s_waitcnt vmcnt(0)" ::: "memory");
        }
    }
    __syncthreads();
}

DI void item_signal(unsigned* ctr) {
    asm volatile("s_waitcnt vmcnt(0)" ::: "memory");
    __syncthreads();
    if (threadIdx.x == 0) { __builtin_amdgcn_fence(__ATOMIC_RELEASE, "agent"); asm volatile("s_waitcnt vmcnt(0)" ::: "memory"); ab_add(ctr, 1u); }
}
DI void item_wait(unsigned* ctr, unsigned target) {
    if (threadIdx.x == 0) { AB_SPIN(ab_ld(ctr) < target); __builtin_amdgcn_fence(__ATOMIC_ACQUIRE, "agent"); asm volatile("s_waitcnt vmcnt(0)" ::: "memory"); }
    __syncthreads();
}

DI void st16_wt(void* p, f32x4 v) { asm volatile("s_nop 1\n\tglobal_store_dwordx4 %0, %1, off sc1\n\ts_nop 1" :: "v"(p), "v"(v) : "memory"); }
DI void st16_wt(void* p, u32x4 v) { asm volatile("s_nop 1\n\tglobal_store_dwordx4 %0, %1, off sc1\n\ts_nop 1" :: "v"(p), "v"(v) : "memory"); }
DI void st8_wt(void* p, f32x2 v) { __hip_atomic_store((unsigned long long*)p, __builtin_bit_cast(unsigned long long, v), __ATOMIC_RELAXED, __HIP_MEMORY_SCOPE_AGENT); }
DI void item_signal_wt(unsigned* ctr) {
    asm volatile("s_waitcnt vmcnt(0)" ::: "memory");
    __syncthreads();
    if (threadIdx.x == 0) ab_add(ctr, 1u);
}

DI int rowbase(int pm) { return (pm >> 3) * LP + 128 + (pm & 7) * 256; }
namespace pg8 {
constexpr int BM = 256, BK = 64, HALF = 128, HTB = HALF * BK * 2, STAGE_BYTES = 8 * HTB, NXCD = 8, WGM = 8;
DI int lds_byte(int r, int c) { const int st = (r >> 4) * 2 + (c >> 5), rr = r & 15, cc = c & 31, ob = rr * 64 + cc * 2; return st * 1024 + (ob ^ (((ob >> 9) & 1) << 5)); }
DI void stage_rc(int b, int& R, int& C) { const int st = b / 1024, sb = b % 1024, swz = sb ^ (((sb >> 9) & 1) << 5); R = (st >> 1) * 16 + swz / 64; C = (st & 1) * 32 + (swz % 64) / 2; }
DI int perm32(int rho) { const int n = rho >> 4, i = rho & 15; return 8 * (i >> 2) + 4 * n + (i & 3); }
struct Unit { int pm, pn; };
struct Gemm { const bf16_t* A; const bf16_t* Bt; int M, N, K; };
struct StaticOrder {
    int nM, nN, nwg, G, c;
    DI void init(int M, int N, int G_, int c_) { nM = M / BM; nN = N / BM; nwg = nM * nN; G = G_; c = c_; }
    DI bool next(int i, Unit& u) const {
        const long L = (long)i * G + c; if (L >= nwg) return false;
        int wgid = (int)L; { const int q = nwg / NXCD, r = nwg % NXCD, xcd = wgid % NXCD, off = wgid / NXCD; wgid = (xcd < r ? xcd * (q + 1) : r * (q + 1) + (xcd - r) * q) + off; }
        const int nig = WGM * nN, gid = wgid / nig, fm = gid * WGM, gsz = (nM - fm) < WGM ? (nM - fm) : WGM;
        u.pm = fm + ((wgid % nig) % gsz); u.pn = (wgid % nig) / gsz; return true;
    }
    DI void a_ready(const Unit&) const {}
    DI void done(const Unit&) const {}
};

template <class Epi, class Sched>
DI void gemm_phase(LAS unsigned char* lds, const Gemm g, const Sched& S, const Epi& E) {
    const int tid = opaque_tid(), wid = __builtin_amdgcn_readfirstlane(tid >> 6), lane = tid & 63, wr = wid >> 2, wc = wid & 3, fr = lane & 15, fq = lane >> 4;
    const int K = g.K, nt = K / BK;
    unsigned voffA[2], voffB[2];
#pragma unroll
    for (int i = 0; i < 2; ++i) { int R, C; stage_rc(tid * 16 + i * 8192, R, C); const int Rb = Epi::PERM ? ((R & ~31) + perm32(R & 31)) : R;
        voffA[i] = (unsigned)(R * K + C) * 2u; voffB[i] = (unsigned)(Rb * K + C) * 2u; }
    const size_t kstep = (size_t)(BK * 2);
    const size_t hstep = (size_t)HALF * K * 2;
    const size_t tstep = 2 * hstep;
    const unsigned ldsw = (unsigned)wid * 1024u;
    const int aoff = lds_byte(wr * 64 + fr, fq * 8), boff = lds_byte(wc * 32 + fr, fq * 8);
#define PG8_SA(b, h) (((b) * 2 + (h)) * HTB)
#define PG8_SB(b, h) ((4 + (b) * 2 + (h)) * HTB)
#define PG8_STAGE(bufoff, gbase, voff) do { _Pragma("unroll") for (int _i = 0; _i < 2; ++_i) \
        __builtin_amdgcn_global_load_lds((const unsigned*)((const char*)(gbase) + (voff)[_i]), (LAS unsigned*)(lds + (bufoff) + ldsw + _i * 8192), 16, 0, 0); } while (0)
#define PG8_LDA(dst, b, h) do { _Pragma("unroll") for (int m = 0; m < 4; ++m) _Pragma("unroll") for (int k = 0; k < 2; ++k) dst[m][k] = *(const LAS bf16x8*)(lds + PG8_SA(b, h) + aoff + m * 2048 + k * 1024); } while (0)
#define PG8_LDB(dst, b, h) do { _Pragma("unroll") for (int n = 0; n < 2; ++n) _Pragma("unroll") for (int k = 0; k < 2; ++k) dst[n][k] = *(const LAS bf16x8*)(lds + PG8_SB(b, h) + boff + n * 2048 + k * 1024); } while (0)
#define PG8_MMA(ai, bj, At, Bt) do { __builtin_amdgcn_s_setprio(1); _Pragma("unroll") for (int m = 0; m < 4; ++m) _Pragma("unroll") for (int n = 0; n < 2; ++n) _Pragma("unroll") for (int k = 0; k < 2; ++k) \
        acc[ai][bj][m][n] = __builtin_amdgcn_mfma_f32_16x16x32_bf16(Bt[n][k], At[m][k], acc[ai][bj][m][n], 0, 0, 0); __builtin_amdgcn_s_setprio(0); } while (0)
#define PG8_WAIT_V(n) asm volatile("s_waitcnt vmcnt(" #n ")" ::: "memory")
#define PG8_WAIT_L(n) asm volatile("s_waitcnt lgkmcnt(" #n ")" ::: "memory")
#define PG8_BAR __builtin_amdgcn_s_barrier()
#define PG8_SCHED __builtin_amdgcn_sched_barrier(0)
    Unit cur, nxt; int ui = 0;
    if (!S.next(0, cur)) return;
    f32x4 acc[2][2][4][2];
#pragma unroll
    for (int a = 0; a < 2; ++a)
#pragma unroll
        for (int b = 0; b < 2; ++b)
#pragma unroll
            for (int m = 0; m < 4; ++m)
#pragma unroll
                for (int n = 0; n < 2; ++n) acc[a][b][m][n] = (f32x4){0.f, 0.f, 0.f, 0.f};
    bf16x8 At[4][2], B0[2][2], B1[2][2];
    const char* cA = (const char*)g.A + (size_t)rowbase(cur.pm) * K * 2; const char* cB = (const char*)g.Bt + (size_t)cur.pn * tstep;
    S.a_ready(cur);
    PG8_STAGE(PG8_SB(0, 0), cB, voffB); PG8_STAGE(PG8_SA(0, 0), cA, voffA); PG8_STAGE(PG8_SB(0, 1), cB + hstep, voffB); PG8_STAGE(PG8_SA(0, 1), cA + hstep, voffA);
    if (wr == 1) PG8_BAR;
    PG8_WAIT_V(4); PG8_BAR;
    PG8_STAGE(PG8_SB(1, 0), cB + kstep, voffB); PG8_STAGE(PG8_SA(1, 0), cA + kstep, voffA); PG8_STAGE(PG8_SB(1, 1), cB + hstep + kstep, voffB);
    PG8_WAIT_V(6); PG8_BAR;
    for (;;) {
        const bool has_next = S.next(ui + 1, nxt);
        const char* nA = has_next ? (const char*)g.A + (size_t)rowbase(nxt.pm) * K * 2 : cA; const char* nB = has_next ? (const char*)g.Bt + (size_t)nxt.pn * tstep : cB;
        constexpr int NH = Epi::MID_HOOK ? 2 : 1;
#pragma nounroll
        for (int hh = 0; hh < NH; ++hh) {
        if constexpr (Epi::MID_HOOK) { if (hh == 1) { const int l2 = opaque_tid() & 63; E.mid(acc, cur, wr, wc, l2 & 15, l2 >> 4); } }
        for (int t = hh * (nt / NH); t < (hh + 1) * (nt / NH); t += 2) {
            const bool last = (t == nt - 2);
            const char* a1 = cA + (size_t)(t + 1) * kstep;
            const char* a2 = last ? nA : cA + (size_t)(t + 2) * kstep; const char* b2 = last ? nB : cB + (size_t)(t + 2) * kstep;
            const char* a3 = a2 + kstep; const char* b3 = b2 + kstep;
            if (last && has_next) S.a_ready(nxt);
            PG8_LDB(B0, 0, 0); PG8_SCHED; PG8_LDA(At, 0, 0); PG8_STAGE(PG8_SA(1, 1), a1 + hstep, voffA);
            PG8_WAIT_L(8); PG8_BAR; PG8_WAIT_L(0); PG8_MMA(0, 0, At, B0); PG8_BAR; PG8_SCHED;
            PG8_LDB(B1, 0, 1); PG8_STAGE(PG8_SB(0, 0), b2, voffB);
            PG8_BAR; PG8_WAIT_L(0); PG8_MMA(0, 1, At, B1); PG8_BAR;
            PG8_LDA(At, 0, 1); PG8_STAGE(PG8_SA(0, 0), a2, voffA);
            PG8_BAR; PG8_WAIT_L(0); PG8_MMA(1, 0, At, B0); PG8_BAR; PG8_SCHED;
            PG8_STAGE(PG8_SB(0, 1), b2 + hstep, voffB);
            PG8_WAIT_V(6); PG8_BAR; PG8_MMA(1, 1, At, B1); PG8_BAR;
            PG8_LDB(B0, 1, 0); PG8_SCHED; PG8_LDA(At, 1, 0); PG8_STAGE(PG8_SA(0, 1), a2 + hstep, voffA);
            PG8_WAIT_L(8); PG8_BAR; PG8_WAIT_L(0); PG8_MMA(0, 0, At, B0); PG8_BAR; PG8_SCHED;
            PG8_LDB(B1, 1, 1); PG8_STAGE(PG8_SB(1, 0), b3, voffB);
            PG8_BAR; PG8_WAIT_L(0); PG8_MMA(0, 1, At, B1); PG8_BAR;
            PG8_LDA(At, 1, 1); PG8_STAGE(PG8_SA(1, 0), a3, voffA);
            PG8_BAR; PG8_WAIT_L(0); PG8_MMA(1, 0, At, B0); PG8_BAR; PG8_SCHED;
            PG8_STAGE(PG8_SB(1, 1), b3 + hstep, voffB);
            PG8_WAIT_V(6); PG8_BAR; PG8_MMA(1, 1, At, B1); PG8_BAR;
        }
        }
        if constexpr (!Epi::AFTER_DRAIN) { const int l2 = opaque_tid() & 63; E(acc, cur, wr, wc, l2 & 15, l2 >> 4); } S.done(cur);
        if (!has_next) break;
#pragma unroll
        for (int a = 0; a < 2; ++a)
#pragma unroll
            for (int b = 0; b < 2; ++b)
#pragma unroll
                for (int m = 0; m < 4; ++m)
#pragma unroll
                    for (int n = 0; n < 2; ++n) acc[a][b][m][n] = (f32x4){0.f, 0.f, 0.f, 0.f};
        cur = nxt; cA = nA; cB = nB; ++ui;
    }
    PG8_WAIT_V(0);
    if (wr == 0) PG8_BAR;
    PG8_BAR;
    if constexpr (Epi::AFTER_DRAIN) { const int l2 = opaque_tid() & 63; E.fused(acc, cur, wr, wc, l2 & 15, l2 >> 4); }
#undef PG8_SA
#undef PG8_SB
#undef PG8_STAGE
#undef PG8_LDA
#undef PG8_LDB
#undef PG8_MMA
#undef PG8_WAIT_V
#undef PG8_WAIT_L
#undef PG8_BAR
#undef PG8_SCHED
}
}
using pg8::Unit;

struct EpiIn {
    static constexpr bool PERM = true, AFTER_DRAIN = false, MID_HOOK = false;
    bf16_t* P; const float* TA; const float* TR;
    template <int KIND> DI void g8k(int row, int col, f32x4 v0, f32x4 v1) const {
        const int l = row % LP;
        if (KIND == 0 || KIND == 2) {
            const float* t = (KIND == 0) ? TA + ((size_t)l * 32 + ((col & 63) >> 1)) * 2 : TR + ((size_t)l * 64 + ((col & 127) >> 1)) * 2;
            const f32x4 t0 = *(const f32x4*)t, t1 = *(const f32x4*)(t + 4);
            f32x4 w0, w1;
            w0[0] = v0[0] * t0[0] - v0[1] * t0[1]; w0[1] = v0[1] * t0[0] + v0[0] * t0[1];
            w0[2] = v0[2] * t0[2] - v0[3] * t0[3]; w0[3] = v0[3] * t0[2] + v0[2] * t0[3];
            w1[0] = v1[0] * t1[0] - v1[1] * t1[1]; w1[1] = v1[1] * t1[0] + v1[0] * t1[1];
            w1[2] = v1[2] * t1[2] - v1[3] * t1[3]; w1[3] = v1[3] * t1[2] + v1[2] * t1[3];
            v0 = w0; v1 = w1;
            if (KIND == 2 && col >= C_RK) { const float sc = (l >= PADR) ? 0.08838834764831845f : 0.0f; v0 *= sc; v1 *= sc; }
        }
        if (KIND == 3) {
#pragma unroll
            for (int j = 0; j < 4; ++j) { v0[j] = v0[j] * sigmoidf_(v0[j]); v1[j] = v1[j] * sigmoidf_(v1[j]); }
        }
        if (KIND == 4) {
#pragma unroll
            for (int j = 0; j < 4; ++j) { v0[j] = sigmoidf_(v0[j]); v1[j] = sigmoidf_(v1[j]); }
        }
        u32x4 w; w.x = pk2(v0[0], v0[1]); w.y = pk2(v0[2], v0[3]); w.z = pk2(v1[0], v1[1]); w.w = pk2(v1[2], v1[3]);
        *(u32x4*)(P + (size_t)row * PLD + col) = w;
    }
    DI void g8(int row, int col, f32x4 v0, f32x4 v1) const {
        const int pn = col >> 8;
        if (pn < 16) g8k<0>(row, col, v0, v1);
        else if (pn < 24) g8k<1>(row, col, v0, v1);
        else if (pn < 32) g8k<2>(row, col, v0, v1);
        else if (pn < 40) g8k<1>(row, col, v0, v1);
        else if (pn < 48) g8k<3>(row, col, v0, v1);
        else g8k<4>(row, col, v0, v1);
    }
    template <int KIND> DI void g8rot(int row, int col, f32x4 v0, f32x4 v1, const f32x4 t0, const f32x4 t1) const {
        f32x4 w0, w1;
        w0[0] = v0[0] * t0[0] - v0[1] * t0[1]; w0[1] = v0[1] * t0[0] + v0[0] * t0[1];
        w0[2] = v0[2] * t0[2] - v0[3] * t0[3]; w0[3] = v0[3] * t0[2] + v0[2] * t0[3];
        w1[0] = v1[0] * t1[0] - v1[1] * t1[1]; w1[1] = v1[1] * t1[0] + v1[0] * t1[1];
        w1[2] = v1[2] * t1[2] - v1[3] * t1[3]; w1[3] = v1[3] * t1[2] + v1[2] * t1[3];
        if (KIND == 2 && col >= C_RK) { const float sc = ((row % LP) >= PADR) ? 0.08838834764831845f : 0.0f; w0 *= sc; w1 *= sc; }
        u32x4 w; w.x = pk2(w0[0], w0[1]); w.y = pk2(w0[2], w0[3]); w.z = pk2(w1[0], w1[1]); w.w = pk2(w1[2], w1[3]);
        *(u32x4*)(P + (size_t)row * PLD + col) = w;
    }
    template <int KIND> DI void run(const f32x4 (&acc)[2][2][4][2], const Unit& u, int wr, int wc, int fr, int fq) const {
        int row0 = rowbase(u.pm) + wr * 64 + fr, col0 = u.pn * 256 + wc * 32 + 8 * fq;
        asm volatile("" : "+v"(row0), "+v"(col0));
        if constexpr (KIND == 0 || KIND == 2) {
#pragma unroll
            for (int ai = 0; ai < 2; ++ai) {
                f32x4 ta[4], tb[4];
#pragma unroll
                for (int m = 0; m < 4; ++m) {
                    const int l = (row0 + ai * 128 + m * 16) % LP;
                    const float* t = (KIND == 0) ? TA + ((size_t)l * 32 + ((col0 & 63) >> 1)) * 2 : TR + ((size_t)l * 64 + ((col0 & 127) >> 1)) * 2;
                    ta[m] = *(const f32x4*)t; tb[m] = *(const f32x4*)(t + 4);
                }
                __builtin_amdgcn_sched_barrier(0);
#pragma unroll
                for (int m = 0; m < 4; ++m)
#pragma unroll
                    for (int bj = 0; bj < 2; ++bj) { g8rot<KIND>(row0 + ai * 128 + m * 16, col0 + bj * 128, acc[ai][bj][m][0], acc[ai][bj][m][1], ta[m], tb[m]); __builtin_amdgcn_sched_barrier(0); }
            }
        } else {
#pragma unroll
            for (int ai = 0; ai < 2; ++ai)
#pragma unroll
                for (int m = 0; m < 4; ++m)
#pragma unroll
                    for (int bj = 0; bj < 2; ++bj) { g8k<KIND>(row0 + ai * 128 + m * 16, col0 + bj * 128, acc[ai][bj][m][0], acc[ai][bj][m][1]); __builtin_amdgcn_sched_barrier(0); }
        }
    }
    DI void operator()(const f32x4 (&acc)[2][2][4][2], const Unit& u, int wr, int wc, int fr, int fq) const {
        const int pn = u.pn;
        if (pn < 16) run<0>(acc, u, wr, wc, fr, fq);
        else if (pn < 24) run<1>(acc, u, wr, wc, fr, fq);
        else if (pn < 32) run<2>(acc, u, wr, wc, fr, fq);
        else if (pn < 40) run<1>(acc, u, wr, wc, fr, fq);
        else if (pn < 48) run<3>(acc, u, wr, wc, fr, fq);
        else run<4>(acc, u, wr, wc, fr, fq);
    }
};
template <int WHICH> struct EpiBr {
    static constexpr bool PERM = true, AFTER_DRAIN = false, MID_HOOK = false;
    const bf16_t* P; float* TMP; bf16_t* MG;
    DI void g8(int row, int col, f32x4 a0, f32x4 a1) const {
        const u32x4 gw = *(const u32x4*)(P + (size_t)row * PLD + (WHICH == 0 ? C_GA : C_GB) + col);
        f32x4 g0, g1;
        g0[0] = bf2f(gw.x & 0xffffu); g0[1] = bf2f(gw.x >> 16); g0[2] = bf2f(gw.y & 0xffffu); g0[3] = bf2f(gw.y >> 16);
        g1[0] = bf2f(gw.z & 0xffffu); g1[1] = bf2f(gw.z >> 16); g1[2] = bf2f(gw.w & 0xffffu); g1[3] = bf2f(gw.w >> 16);
        f32x4 v0 = a0 * g0, v1 = a1 * g1;
        float* tp = TMP + (size_t)row * D + col;
        if (WHICH == 0) { *(f32x4*)tp = v0; *(f32x4*)(tp + 4) = v1; }
        else {
            v0 += *(const f32x4*)tp; v1 += *(const f32x4*)(tp + 4);
            u32x4 w; w.x = pk2(v0[0], v0[1]); w.y = pk2(v0[2], v0[3]); w.z = pk2(v1[0], v1[1]); w.w = pk2(v1[2], v1[3]);
            *(u32x4*)(MG + (size_t)row * D + col) = w;
        }
    }
    DI void operator()(const f32x4 (&acc)[2][2][4][2], const Unit& u, int wr, int wc, int fr, int fq) const {
        const int row0 = rowbase(u.pm) + wr * 64 + fr, col0 = u.pn * 256 + wc * 32 + 8 * fq;
#pragma unroll
        for (int ai = 0; ai < 2; ++ai)
#pragma unroll
            for (int m = 0; m < 4; ++m)
#pragma unroll
                for (int bj = 0; bj < 2; ++bj) g8(row0 + ai * 128 + m * 16, col0 + bj * 128, acc[ai][bj][m][0], acc[ai][bj][m][1]);
    }
};
struct EpiRes {
    static constexpr bool PERM = false, AFTER_DRAIN = false, MID_HOOK = false;
    const float* HF; float* PRE;
    DI void g4(int row, int col, f32x4 a) const {
        const size_t o = (size_t)row * D + col;
        *(f32x4*)(PRE + o) = *(const f32x4*)(HF + o) * ALPHA + a;
    }
    DI void g8(int row, int col, f32x4 a0, f32x4 a1) const { g4(row, col, a0); g4(row, col + 4, a1); }
    DI void operator()(const f32x4 (&acc)[2][2][4][2], const Unit& u, int wr, int wc, int fr, int fq) const {
        const int row0 = rowbase(u.pm) + wr * 64 + fr, col0 = u.pn * 256 + wc * 32 + 4 * fq;
#pragma unroll
        for (int ai = 0; ai < 2; ++ai)
#pragma unroll
            for (int m = 0; m < 4; ++m)
#pragma unroll
                for (int bj = 0; bj < 2; ++bj)
#pragma unroll
                    for (int n = 0; n < 2; ++n) g4(row0 + ai * 128 + m * 16, col0 + bj * 128 + n * 16, acc[ai][bj][m][n]);
    }
};
struct EpiUp {
    static constexpr bool PERM = true, AFTER_DRAIN = false, MID_HOOK = false;
    bf16_t* U;
    DI void g8(int row, int col, f32x4 v0, f32x4 v1) const {
        u32x4 w; w.x = pk2(v0[0], v0[1]); w.y = pk2(v0[2], v0[3]); w.z = pk2(v1[0], v1[1]); w.w = pk2(v1[2], v1[3]);
        *(u32x4*)(U + (size_t)row * DFF2 + col) = w;
    }
    DI void operator()(const f32x4 (&acc)[2][2][4][2], const Unit& u, int wr, int wc, int fr, int fq) const {
        int row0 = rowbase(u.pm) + wr * 64 + fr, col0 = u.pn * 256 + wc * 32 + 8 * fq;
        asm volatile("" : "+v"(row0), "+v"(col0));
#pragma unroll
        for (int ai = 0; ai < 2; ++ai)
#pragma unroll
            for (int m = 0; m < 4; ++m)
#pragma unroll
                for (int bj = 0; bj < 2; ++bj) g8(row0 + ai * 128 + m * 16, col0 + bj * 128, acc[ai][bj][m][0], acc[ai][bj][m][1]);
    }
};

template <class Epi> DI void meta_gemm(const bf16_t* __restrict__ A, const bf16_t* __restrict__ Bt, int N, int K, const Epi& E, unsigned char* smem) {
    const int tid = opaque_tid(), wid = __builtin_amdgcn_readfirstlane(tid >> 6), lane = tid & 63, i16 = lane & 15, kq = lane >> 4;
    float* R = (float*)smem;
    const int nsteps = K / 32, s0 = (wid * nsteps) >> 3, s1 = ((wid + 1) * nsteps) >> 3;
    const bf16_t* ap = A + (size_t)(PADR + i16) * K + 8 * kq;
    for (int task = blockIdx.x; task < N / 32; task += gridDim.x) {
        const int cbase = task * 32;
        const bf16_t* w0 = Bt + (size_t)(cbase + 8 * (i16 >> 2) + (i16 & 3)) * K + 8 * kq;
        const bf16_t* w1 = w0 + (size_t)4 * K;
        f32x4 c0 = {0.f, 0.f, 0.f, 0.f}, c1 = {0.f, 0.f, 0.f, 0.f};
#pragma unroll 4
        for (int st = s0; st < s1; ++st) {
            const bf16x8 af = *(const bf16x8*)(ap + st * 32);
            const bf16x8 b0 = *(const bf16x8*)(w0 + st * 32), b1 = *(const bf16x8*)(w1 + st * 32);
            c0 = __builtin_amdgcn_mfma_f32_16x16x32_bf16(b0, af, c0, 0, 0, 0);
            c1 = __builtin_amdgcn_mfma_f32_16x16x32_bf16(b1, af, c1, 0, 0, 0);
        }
        *(f32x4*)(R + ((wid * 2 + 0) * 64 + lane) * 4) = c0;
        *(f32x4*)(R + ((wid * 2 + 1) * 64 + lane) * 4) = c1;
        __syncthreads();
        if (wid == 0) {
            f32x4 v0 = {0.f, 0.f, 0.f, 0.f}, v1 = {0.f, 0.f, 0.f, 0.f};
#pragma unroll
            for (int w = 0; w < 8; ++w) { v0 += *(const f32x4*)(R + ((w * 2 + 0) * 64 + lane) * 4); v1 += *(const f32x4*)(R + ((w * 2 + 1) * 64 + lane) * 4); }
            for (int b = 0; b < NB; ++b) E.g8(b * LP + PADR + i16, cbase + 8 * kq, v0, v1);
        }
        __syncthreads();
    }
}


struct EpiMerge {
    static constexpr bool PERM = true, AFTER_DRAIN = false, MID_HOOK = true;
    const bf16_t* P; bf16_t* MG;
    DI static void unpack8(const u32x4 gw, f32x4& g0, f32x4& g1) {
        g0[0] = bf2f(gw.x & 0xffffu); g0[1] = bf2f(gw.x >> 16); g0[2] = bf2f(gw.y & 0xffffu); g0[3] = bf2f(gw.y >> 16);
        g1[0] = bf2f(gw.z & 0xffffu); g1[1] = bf2f(gw.z >> 16); g1[2] = bf2f(gw.w & 0xffffu); g1[3] = bf2f(gw.w >> 16);
    }
    DI void mid(f32x4 (&acc)[2][2][4][2], const Unit& u, int wr, int wc, int fr, int fq) const {
        int row0 = rowbase(u.pm) + wr * 64 + fr, col0 = u.pn * 256 + wc * 32 + 8 * fq;
        asm volatile("" : "+v"(row0), "+v"(col0));
#pragma unroll
        for (int ai = 0; ai < 2; ++ai)
#pragma unroll
            for (int m = 0; m < 4; ++m)
#pragma unroll
                for (int bj = 0; bj < 2; ++bj) {
                    const bf16_t* gp = P + (size_t)(row0 + ai * 128 + m * 16) * PLD + col0 + bj * 128;
                    f32x4 a0, a1, b0, b1;
                    unpack8(*(const u32x4*)(gp + C_GA), a0, a1); unpack8(*(const u32x4*)(gp + C_GB), b0, b1);
#pragma unroll
                    for (int j = 0; j < 4; ++j) { acc[ai][bj][m][0][j] *= a0[j] * __builtin_amdgcn_rcpf(b0[j]); acc[ai][bj][m][1][j] *= a1[j] * __builtin_amdgcn_rcpf(b1[j]); }
                    asm volatile("" ::: "memory");
                }
    }
    DI void operator()(const f32x4 (&acc)[2][2][4][2], const Unit& u, int wr, int wc, int fr, int fq) const {
        int row0 = rowbase(u.pm) + wr * 64 + fr, col0 = u.pn * 256 + wc * 32 + 8 * fq;
        asm volatile("" : "+v"(row0), "+v"(col0));
#pragma unroll
        for (int ai = 0; ai < 2; ++ai)
#pragma unroll
            for (int m = 0; m < 4; ++m)
#pragma unroll
                for (int bj = 0; bj < 2; ++bj) {
                    const int row = row0 + ai * 128 + m * 16, col = col0 + bj * 128;
                    f32x4 b0, b1;
                    unpack8(*(const u32x4*)(P + (size_t)row * PLD + C_GB + col), b0, b1);
                    const f32x4 v0 = acc[ai][bj][m][0] * b0, v1 = acc[ai][bj][m][1] * b1;
                    u32x4 w; w.x = pk2(v0[0], v0[1]); w.y = pk2(v0[2], v0[3]); w.z = pk2(v1[0], v1[1]); w.w = pk2(v1[2], v1[3]);
                    *(u32x4*)(MG + (size_t)row * D + col) = w;
                }
    }
};
DI void meta_gemm_merge(const bf16_t* __restrict__ A, const bf16_t* __restrict__ Bt, const EpiMerge& E, unsigned char* smem) {
    const int tid = opaque_tid(), wid = __builtin_amdgcn_readfirstlane(tid >> 6), lane = tid & 63, i16 = lane & 15, kq = lane >> 4;
    float* R = (float*)smem;
    constexpr int K2 = 2 * D, nsteps = K2 / 32;
    const int s0 = (wid * nsteps) >> 3, s1 = ((wid + 1) * nsteps) >> 3;
    const bf16_t* ap = A + (size_t)(PADR + i16) * K2 + 8 * kq;
    const int task = blockIdx.x;
    if (task >= D / 32) return;
    const int cbase = task * 32;
    const bf16_t* w0 = Bt + (size_t)(cbase + 8 * (i16 >> 2) + (i16 & 3)) * K2 + 8 * kq;
    const bf16_t* w1 = w0 + (size_t)4 * K2;
    f32x4 c0 = {0.f, 0.f, 0.f, 0.f}, c1 = {0.f, 0.f, 0.f, 0.f};
#pragma unroll 4
    for (int st = s0; st < s1; ++st) {
        const bf16x8 af = *(const bf16x8*)(ap + st * 32);
        const bf16x8 b0 = *(const bf16x8*)(w0 + st * 32), b1 = *(const bf16x8*)(w1 + st * 32);
        c0 = __builtin_amdgcn_mfma_f32_16x16x32_bf16(b0, af, c0, 0, 0, 0);
        c1 = __builtin_amdgcn_mfma_f32_16x16x32_bf16(b1, af, c1, 0, 0, 0);
    }
    *(f32x4*)(R + ((wid * 2 + 0) * 64 + lane) * 4) = c0;
    *(f32x4*)(R + ((wid * 2 + 1) * 64 + lane) * 4) = c1;
    __syncthreads();
    if (wid == 0) {
        f32x4 a0 = {0.f, 0.f, 0.f, 0.f}, a1 = a0, b0 = a0, b1 = a0;
#pragma unroll
        for (int w = 0; w < 4; ++w) { a0 += *(const f32x4*)(R + ((w * 2 + 0) * 64 + lane) * 4); a1 += *(const f32x4*)(R + ((w * 2 + 1) * 64 + lane) * 4); }
#pragma unroll
        for (int w = 4; w < 8; ++w) { b0 += *(const f32x4*)(R + ((w * 2 + 0) * 64 + lane) * 4); b1 += *(const f32x4*)(R + ((w * 2 + 1) * 64 + lane) * 4); }
        const int col = cbase + 8 * kq;
        const bf16_t* gp = E.P + (size_t)(PADR + i16) * PLD + col;
        f32x4 ga0, ga1, gb0, gb1;
        EpiMerge::unpack8(*(const u32x4*)(gp + C_GA), ga0, ga1); EpiMerge::unpack8(*(const u32x4*)(gp + C_GB), gb0, gb1);
        const f32x4 v0 = a0 * ga0 + b0 * gb0, v1 = a1 * ga1 + b1 * gb1;
        u32x4 w; w.x = pk2(v0[0], v0[1]); w.y = pk2(v0[2], v0[3]); w.z = pk2(v1[0], v1[1]); w.w = pk2(v1[2], v1[3]);
        for (int bb = 0; bb < NB; ++bb) *(u32x4*)(E.MG + (size_t)(bb * LP + PADR + i16) * D + col) = w;
    }
    __syncthreads();
}

struct EpiLN {
    static constexpr bool PERM = false, AFTER_DRAIN = true, MID_HOOK = false;
    float* HF; bf16_t* HB; float* OUT; const float* g; const float* b; float* STATS; unsigned* cnt; unsigned char* smem;
    DI void fused(f32x4 (&acc)[2][2][4][2], const Unit& u, int wr, int wc, int fr, int fq) const {
        const int tid = opaque_tid();
        const int rb = rowbase(u.pm), rl0 = wr * 64 + fr, col0 = u.pn * 256 + wc * 32 + 4 * fq;
        float* part = (float*)smem;
        float* mr = part + 2048;
#pragma unroll
        for (int ai = 0; ai < 2; ++ai)
#pragma unroll
            for (int m = 0; m < 4; ++m) {
                const int rl = rl0 + ai * 128 + m * 16;
                const size_t ro = (size_t)(rb + rl) * D + col0;
                float sm = 0.f, sq = 0.f;
#pragma unroll
                for (int bj = 0; bj < 2; ++bj)
#pragma unroll
                    for (int n = 0; n < 2; ++n) {
                        const f32x4 x = *(const f32x4*)(HF + ro + bj * 128 + n * 16) * ALPHA + acc[ai][bj][m][n];
                        acc[ai][bj][m][n] = x;
                        sm += (x[0] + x[1]) + (x[2] + x[3]); sq += (x[0] * x[0] + x[1] * x[1]) + (x[2] * x[2] + x[3] * x[3]);
                    }
                sm += shx(sm, 16); sq += shx(sq, 16);
                sm += shx(sm, 32); sq += shx(sq, 32);
                if (fq == 0) { part[(wc * 256 + rl) * 2] = sm; part[(wc * 256 + rl) * 2 + 1] = sq; }
            }
        __syncthreads();
        if (tid < 256) {
            float S = 0.f, Q = 0.f;
#pragma unroll
            for (int w = 0; w < 4; ++w) { S += part[(w * 256 + tid) * 2]; Q += part[(w * 256 + tid) * 2 + 1]; }
            f32x2 v = {S, Q};
            st8_wt(STATS + ((size_t)(u.pm * 8 + u.pn) * 256 + tid) * 2, v);
        }
        asm volatile("s_waitcnt vmcnt(0)" ::: "memory");
        __syncthreads();
        if (tid == 0) {
            ab_add(cnt + u.pm, 1u);
            AB_SPIN(ab_ld(cnt + u.pm) < 8u);
            __builtin_amdgcn_fence(__ATOMIC_ACQUIRE, "agent"); asm volatile("s_waitcnt vmcnt(0)" ::: "memory");
        }
        __syncthreads();
        if (tid < 256) {
            float S = 0.f, Q = 0.f;
#pragma unroll
            for (int p = 0; p < 8; ++p) { const f32x2 v = *(const f32x2*)(STATS + ((size_t)(u.pm * 8 + p) * 256 + tid) * 2); S += v[0]; Q += v[1]; }
            const float mean = S * (1.0f / D), var = fmaxf(Q * (1.0f / D) - mean * mean, 0.f);
            mr[tid * 2] = mean; mr[tid * 2 + 1] = rsqrtf(var + EPS);
        }
        __syncthreads();
        f32x4 gv[2][2], bv[2][2];
#pragma unroll
        for (int bj = 0; bj < 2; ++bj)
#pragma unroll
            for (int n = 0; n < 2; ++n) { gv[bj][n] = *(const f32x4*)(g + col0 + bj * 128 + n * 16); bv[bj][n] = *(const f32x4*)(b + col0 + bj * 128 + n * 16); }
#pragma unroll
        for (int ai = 0; ai < 2; ++ai)
#pragma unroll
            for (int m = 0; m < 4; ++m) {
                const int rl = rl0 + ai * 128 + m * 16, row = rb + rl;
                const float mean = mr[rl * 2], rstd = mr[rl * 2 + 1];
#pragma unroll
                for (int bj = 0; bj < 2; ++bj)
#pragma unroll
                    for (int n = 0; n < 2; ++n) {
                        const int col = col0 + bj * 128 + n * 16;
                        const f32x4 y = (acc[ai][bj][m][n] - mean) * rstd * gv[bj][n] + bv[bj][n];
                        if (OUT) { const int bb = row / LP, l = row % LP; *(f32x4*)(OUT + ((size_t)bb * SEQ + (l - 128)) * D + col) = y; }
                        else {
                            *(f32x4*)(HF + (size_t)row * D + col) = y;
                            u32x2 w; w.x = pk2(y[0], y[1]); w.y = pk2(y[2], y[3]);
                            *(u32x2*)(HB + (size_t)row * D + col) = w;
                        }
                    }
            }
        __syncthreads();
    }
};
DI void meta_gemm_ln(const bf16_t* __restrict__ A, const bf16_t* __restrict__ Bt, int K, const EpiLN& E, unsigned char* smem) {
    const int tid = opaque_tid(), wid = __builtin_amdgcn_readfirstlane(tid >> 6), lane = tid & 63, i16 = lane & 15, kq = lane >> 4;
    float* R = (float*)smem;
    const int nsteps = K / 32, s0 = (wid * nsteps) >> 3, s1 = ((wid + 1) * nsteps) >> 3;
    const bf16_t* ap = A + (size_t)(PADR + i16) * K + 8 * kq;
    const int task = blockIdx.x;
    if (task >= D / 32) return;
    const int cbase = task * 32;
    const bf16_t* w0 = Bt + (size_t)(cbase + 8 * (i16 >> 2) + (i16 & 3)) * K + 8 * kq;
    const bf16_t* w1 = w0 + (size_t)4 * K;
    f32x4 c0 = {0.f, 0.f, 0.f, 0.f}, c1 = {0.f, 0.f, 0.f, 0.f};
#pragma unroll 4
    for (int st = s0; st < s1; ++st) {
        const bf16x8 af = *(const bf16x8*)(ap + st * 32);
        const bf16x8 b0 = *(const bf16x8*)(w0 + st * 32), b1 = *(const bf16x8*)(w1 + st * 32);
        c0 = __builtin_amdgcn_mfma_f32_16x16x32_bf16(b0, af, c0, 0, 0, 0);
        c1 = __builtin_amdgcn_mfma_f32_16x16x32_bf16(b1, af, c1, 0, 0, 0);
    }
    *(f32x4*)(R + ((wid * 2 + 0) * 64 + lane) * 4) = c0;
    *(f32x4*)(R + ((wid * 2 + 1) * 64 + lane) * 4) = c1;
    __syncthreads();
    if (wid == 0) {
        f32x4 v0 = {0.f, 0.f, 0.f, 0.f}, v1 = {0.f, 0.f, 0.f, 0.f};
#pragma unroll
        for (int w = 0; w < 8; ++w) { v0 += *(const f32x4*)(R + ((w * 2 + 0) * 64 + lane) * 4); v1 += *(const f32x4*)(R + ((w * 2 + 1) * 64 + lane) * 4); }
        const int col = cbase + 8 * kq;
        const size_t o0 = (size_t)(PADR + i16) * D + col;
        v0 += *(const f32x4*)(E.HF + o0) * ALPHA; v1 += *(const f32x4*)(E.HF + o0 + 4) * ALPHA;
        float sm = (v0[0] + v0[1]) + (v0[2] + v0[3]) + (v1[0] + v1[1]) + (v1[2] + v1[3]);
        float sq = (v0[0] * v0[0] + v0[1] * v0[1]) + (v0[2] * v0[2] + v0[3] * v0[3]) + (v1[0] * v1[0] + v1[1] * v1[1]) + (v1[2] * v1[2] + v1[3] * v1[3]);
        sm += shx(sm, 16); sq += shx(sq, 16);
        sm += shx(sm, 32); sq += shx(sq, 32);
        float* SM = E.STATS + (size_t)32 * 8 * 256 * 2;
        if (kq == 0) { f32x2 v = {sm, sq}; st8_wt(SM + (task * 16 + i16) * 2, v); }
        asm volatile("s_waitcnt vmcnt(0)" ::: "memory");
        if (lane == 0) {
            ab_add(E.cnt + 32, 1u);
            AB_SPIN(ab_ld(E.cnt + 32) < 64u);
            __builtin_amdgcn_fence(__ATOMIC_ACQUIRE, "agent"); asm volatile("s_waitcnt vmcnt(0)" ::: "memory");
        }
        __builtin_amdgcn_wave_barrier();
        float S = 0.f, Q = 0.f;
        for (int t = 0; t < 64; ++t) { const f32x2 v = *(const f32x2*)(SM + (t * 16 + i16) * 2); S += v[0]; Q += v[1]; }
        const float mean = S * (1.0f / D), var = fmaxf(Q * (1.0f / D) - mean * mean, 0.f), rstd = rsqrtf(var + EPS);
        const f32x4 g0 = *(const f32x4*)(E.g + col), g1 = *(const f32x4*)(E.g + col + 4), b0 = *(const f32x4*)(E.b + col), b1 = *(const f32x4*)(E.b + col + 4);
        const f32x4 y0 = (v0 - mean) * rstd * g0 + b0, y1 = (v1 - mean) * rstd * g1 + b1;
        u32x4 w; w.x = pk2(y0[0], y0[1]); w.y = pk2(y0[2], y0[3]); w.z = pk2(y1[0], y1[1]); w.w = pk2(y1[2], y1[3]);
        for (int bb = 0; bb < NB; ++bb) {
            const size_t o = (size_t)(bb * LP + PADR + i16) * D + col;
            *(f32x4*)(E.HF + o) = y0; *(f32x4*)(E.HF + o + 4) = y1;
            *(u32x4*)(E.HB + o) = w;
        }
    }
    __syncthreads();
}

DI int win_dst_row(int sc) {
    if (sc < 4096) { const int g = sc & ~63, j = sc & 63; return g + ((j & 31) << 1) + (j >> 5); }
    if (sc >= C_RQ && sc < C_RV) { const int g = sc & ~127, j = sc & 127; return g + ((j & 63) << 1) + (j >> 6); }
    return sc;
}
template <bool PERMW> DI void transpose_convert(const float* __restrict__ src, bf16_t* __restrict__ dst, int K, int N) {
    const int tid = opaque_tid(), wid = tid >> 6, lane = tid & 63;
    const int ntn = N / 64, ntk = (K + 255) / 256, ntile = ntn * ntk;
    for (int t = blockIdx.x; t < ntile; t += gridDim.x) {
        const int tn = t / ntk, tk = t % ntk;
        const int s4 = tn * 64 + (lane & 15) * 4, kb = tk * 256 + (wid * 4 + (lane >> 4)) * 8;
        if (kb < K) {
            f32x4 v[8];
#pragma unroll
            for (int j = 0; j < 8; ++j) v[j] = *(const f32x4*)(src + (size_t)(kb + j) * N + s4);
#pragma unroll
            for (int e = 0; e < 4; ++e) {
                const int n = PERMW ? win_dst_row(s4 + e) : (s4 + e);
                u32x4 w; w.x = pk2(v[0][e], v[1][e]); w.y = pk2(v[2][e], v[3][e]); w.z = pk2(v[4][e], v[5][e]); w.w = pk2(v[6][e], v[7][e]);
                *(u32x4*)(dst + (size_t)n * K + kb) = w;
            }
        }
    }
}

struct CvtTile { const float* src; bf16_t* dst; int K, N, t, ldd; bool perm; };
DI void cvt_load(const CvtTile& c, f32x4 (&v)[8], int& s4, int& kb, int wid, int lane) {
    const int ntk = (c.K + 255) / 256;
    const int tn = c.t / ntk, tk = c.t % ntk;
    s4 = tn * 64 + (lane & 15) * 4; kb = tk * 256 + (wid * 4 + (lane >> 4)) * 8;
    if (kb < c.K) {
#pragma unroll
        for (int j = 0; j < 8; ++j) v[j] = __builtin_nontemporal_load((const f32x4*)(c.src + (size_t)(kb + j) * c.N + s4));
    }
}
DI void cvt_store(const CvtTile& c, const f32x4 (&v)[8], int s4, int kb) {
    if (kb < c.K) {
#pragma unroll
        for (int e = 0; e < 4; ++e) {
            const int n = c.perm ? win_dst_row(s4 + e) : (s4 + e);
            u32x4 w; w.x = pk2(v[0][e], v[1][e]); w.y = pk2(v[2][e], v[3][e]); w.z = pk2(v[4][e], v[5][e]); w.w = pk2(v[6][e], v[7][e]);
            *(u32x4*)(c.dst + (size_t)n * c.ldd + kb) = w;
        }
    }
}
constexpr int CT_SQ = 32 * 8, CT_UP = 172 * 8, CT_DN = 32 * 22, CT_IN = 256 * 8;
constexpr int CT_L0 = 3 * CT_SQ + CT_UP + CT_DN, CT_TOTAL = 2 * CT_L0 + CT_IN, CT_PER_ITEM = 16, CT_ITEMS = (CT_TOTAL + CT_PER_ITEM - 1) / CT_PER_ITEM;
DI CvtTile deferred_tile(unsigned char* ws, int t) {
    CvtTile c; c.perm = false; c.ldd = 0;
    int l = 0;
    if (t >= CT_L0) { t -= CT_L0; l = 1;
        if (t < CT_IN) { c.src = argp(ws, 4) + (size_t)D * WIN; c.dst = (bf16_t*)(ws + WS_WIN + SZ_WIN); c.K = D; c.N = WIN; c.t = t; c.ldd = D; c.perm = true; return c; }
        t -= CT_IN; }
    if (t < CT_SQ) { c.src = argp(ws, 11) + (size_t)l * D * D; c.dst = (bf16_t*)(ws + WS_WA + l * 2 * SZ_SQ); c.K = D; c.N = D; c.t = t; c.ldd = 2 * D; return c; }
    t -= CT_SQ;
    if (t < CT_SQ) { c.src = argp(ws, 12) + (size_t)l * D * D; c.dst = (bf16_t*)(ws + WS_WA + l * 2 * SZ_SQ) + D; c.K = D; c.N = D; c.t = t; c.ldd = 2 * D; return c; }
    t -= CT_SQ;
    if (t < CT_SQ) { c.src = argp(ws, 13) + (size_t)l * D * D; c.dst = (bf16_t*)(ws + WS_WO + l * SZ_SQ); c.K = D; c.N = D; c.t = t; c.ldd = D; return c; }
    t -= CT_SQ;
    if (t < CT_UP) { c.src = argp(ws, 16) + (size_t)l * D * DFF2; c.dst = (bf16_t*)(ws + WS_WUP + l * SZ_WUP); c.K = D; c.N = DFF2; c.t = t; c.ldd = D; return c; }
    t -= CT_UP;
    c.src = argp(ws, 19) + (size_t)l * DFF * D; c.dst = (bf16_t*)(ws + WS_WDN + l * SZ_WDN); c.K = DFF; c.N = D; c.t = t; c.ldd = DFF; return c;
}
DI void convert_deferred_item(unsigned char* ws, int item) {
    const int tid = opaque_tid(), wid = tid >> 6, lane = tid & 63;
    const int t0 = item * CT_PER_ITEM;
#pragma nounroll
    for (int t = t0; t < t0 + CT_PER_ITEM; t += 4) {
        if (t >= CT_TOTAL) break;
        CvtTile c[4]; f32x4 v[4][8]; int s4[4], kb[4];
#pragma unroll
        for (int q = 0; q < 4; ++q) { c[q] = deferred_tile(ws, (t + q < CT_TOTAL) ? t + q : t); }
#pragma unroll
        for (int q = 0; q < 4; ++q) if (t + q < CT_TOTAL) cvt_load(c[q], v[q], s4[q], kb[q], wid, lane);
#pragma unroll
        for (int q = 0; q < 4; ++q) if (t + q < CT_TOTAL) cvt_store(c[q], v[q], s4[q], kb[q]);
    }
}

DI void ln_row(f32x4 (&x)[8], const float* __restrict__ g, const float* __restrict__ b, int lane) {
    float s = 0.f;
#pragma unroll
    for (int j = 0; j < 8; ++j) s += x[j][0] + x[j][1] + x[j][2] + x[j][3];
    const float mu = wave_sum(s) * (1.0f / D);
    float q = 0.f;
#pragma unroll
    for (int j = 0; j < 8; ++j) {
#pragma unroll
        for (int e = 0; e < 4; ++e) { const float d = x[j][e] - mu; q += d * d; }
    }
    const float rstd = rsqrtf(wave_sum(q) * (1.0f / D) + EPS);
#pragma unroll
    for (int j = 0; j < 8; ++j) { const int c = (j * 64 + lane) * 4; const f32x4 gv = *(const f32x4*)(g + c), bv = *(const f32x4*)(b + c);
#pragma unroll
        for (int e = 0; e < 4; ++e) x[j][e] = (x[j][e] - mu) * rstd * gv[e] + bv[e]; }
}
DI void store_h(const f32x4 (&x)[8], float* HF, bf16_t* HB, int row, int lane) {
#pragma unroll
    for (int j = 0; j < 8; ++j) { const int c = (j * 64 + lane) * 4;
        *(f32x4*)(HF + (size_t)row * D + c) = x[j];
        u32x2 w; w.x = pk2(x[j][0], x[j][1]); w.y = pk2(x[j][2], x[j][3]);
        *(u32x2*)(HB + (size_t)row * D + c) = w; }
}

template <int VT> DI void attn_pv2(f32x16& oa, f32x16& ob, unsigned vb, const bf16x8 (&pf)[2][2]) {
    const s16x4 al00 = tr_read<(0) * 320 + VT * 64>(vb), ah00 = tr_read<(8) * 320 + VT * 64>(vb);
    const s16x4 al01 = tr_read<(16) * 320 + VT * 64>(vb), ah01 = tr_read<(24) * 320 + VT * 64>(vb);
    const s16x4 al10 = tr_read<(32) * 320 + VT * 64>(vb), ah10 = tr_read<(40) * 320 + VT * 64>(vb);
    const s16x4 al11 = tr_read<(48) * 320 + VT * 64>(vb), ah11 = tr_read<(56) * 320 + VT * 64>(vb);
    const s16x4 bl00 = tr_read<(0) * 320 + VT * 64 + 64>(vb), bh00 = tr_read<(8) * 320 + VT * 64 + 64>(vb);
    const s16x4 bl01 = tr_read<(16) * 320 + VT * 64 + 64>(vb), bh01 = tr_read<(24) * 320 + VT * 64 + 64>(vb);
    const s16x4 bl10 = tr_read<(32) * 320 + VT * 64 + 64>(vb), bh10 = tr_read<(40) * 320 + VT * 64 + 64>(vb);
    const s16x4 bl11 = tr_read<(48) * 320 + VT * 64 + 64>(vb), bh11 = tr_read<(56) * 320 + VT * 64 + 64>(vb);
    LGKM0();
    oa = MFMA32(PK8(al00, ah00), pf[0][0], oa); ob = MFMA32(PK8(bl00, bh00), pf[0][0], ob);
    oa = MFMA32(PK8(al01, ah01), pf[0][1], oa); ob = MFMA32(PK8(bl01, bh01), pf[0][1], ob);
    oa = MFMA32(PK8(al10, ah10), pf[1][0], oa); ob = MFMA32(PK8(bl10, bh10), pf[1][0], ob);
    oa = MFMA32(PK8(al11, ah11), pf[1][1], oa); ob = MFMA32(PK8(bl11, bh11), pf[1][1], ob);
}
constexpr int AK_STR = 272, AV_STR = 320, AK_BUF = 64 * AK_STR, AV_BUF = 64 * AV_STR, AV_BASE = 2 * AK_BUF;
struct AttnCtx { int r, h, mp, qb, qrow; unsigned lds0, vlane; unsigned char* smem; };
DI void attn_S(f32x16 (&st)[2], const bf16x8 (&bq)[4], const AttnCtx& c, int kc) {
    bf16x8 kf[2][4];
    const unsigned char* kbase = c.smem + kc * AK_BUF + c.r * AK_STR + (c.mp * 64 + c.h * 8) * 2;
#pragma unroll
    for (int ksub = 0; ksub < 2; ++ksub)
#pragma unroll
        for (int ks = 0; ks < 4; ++ks) kf[ksub][ks] = *(const bf16x8*)(kbase + ksub * 32 * AK_STR + ks * 32);
#pragma unroll
    for (int i = 0; i < 16; ++i) { st[0][i] = 0.f; st[1][i] = 0.f; }
    LGKM0();
#pragma unroll
    for (int ks = 0; ks < 4; ++ks) { st[0] = MFMA32(kf[0][ks], bq[ks], st[0]); st[1] = MFMA32(kf[1][ks], bq[ks], st[1]); }
}
DI void attn_softmax(f32x16 (&st)[2], bf16x8 (&pf)[2][2], f32x16 (&ot)[4], float& mrun, float& lrun, const AttnCtx& c, int kt) {
    const float CS = 0.125f * 1.4426950408889634f;
    const bool need_mask = (kt < 2) || (kt >= 2 * c.qb);
#pragma unroll
    for (int ksub = 0; ksub < 2; ++ksub)
#pragma unroll
        for (int i = 0; i < 16; ++i) st[ksub][i] *= CS;
    if (need_mask) {
#pragma unroll
        for (int ksub = 0; ksub < 2; ++ksub)
#pragma unroll
            for (int i = 0; i < 16; ++i) {
                const int key = kt * 64 + ksub * 32 + crow(i, c.h);
                const bool ok = (key <= c.qrow) && (key >= PADR || key == c.qrow);
                st[ksub][i] = ok ? st[ksub][i] : -1e30f;
            }
    }
    float mx = -INFINITY;
#pragma unroll
    for (int ksub = 0; ksub < 2; ++ksub)
#pragma unroll
        for (int i = 0; i < 16; ++i) mx = fmaxf(mx, st[ksub][i]);
    mx = fmaxf(mx, shx(mx, 32));
    const bool raise = (mx - mrun) > 8.0f;
    const float mnew = raise ? mx : mrun;
    const float alpha = raise ? fexp2(mrun - mnew) : 1.0f;
    mrun = mnew;
    float ls = 0.f;
#pragma unroll
    for (int ksub = 0; ksub < 2; ++ksub)
#pragma unroll
        for (int i = 0; i < 16; ++i) { const float p = fexp2(st[ksub][i] - mnew); st[ksub][i] = p; ls += p; }
    lrun = lrun * alpha + ls;
    if (__builtin_amdgcn_ballot_w64(alpha != 1.0f) != 0ull) {
#pragma unroll
        for (int v = 0; v < 4; ++v)
#pragma unroll
            for (int i = 0; i < 16; ++i) ot[v][i] *= alpha;
    }
#pragma unroll
    for (int ksub = 0; ksub < 2; ++ksub)
#pragma unroll
        for (int s = 0; s < 2; ++s)
            pf[ksub][s] = pack8(st[ksub][8 * s], st[ksub][8 * s + 1], st[ksub][8 * s + 2], st[ksub][8 * s + 3], st[ksub][8 * s + 4], st[ksub][8 * s + 5], st[ksub][8 * s + 6], st[ksub][8 * s + 7]);
}
DI void attn_PV(f32x16 (&ot)[4], const bf16x8 (&pf)[2][2], const AttnCtx& c, int vc) {
    const unsigned vb = c.lds0 + AV_BASE + vc * AV_BUF + c.vlane;
    attn_pv2<0>(ot[0], ot[1], vb, pf); attn_pv2<2>(ot[2], ot[3], vb, pf);
}
DI void attn_item(const bf16_t* __restrict__ P, bf16_t* __restrict__ OA, const float* __restrict__ subg, float lam, float one_m_li,
                  int b, int hd, int qb, unsigned char* smem) {
    const int tid = opaque_tid(), wid = __builtin_amdgcn_readfirstlane(tid >> 6), lane = tid & 63, r = lane & 31, h = lane >> 5;
    const int mp = wid >> 2, qs = wid & 3;
    const bf16_t* Pb = P + (size_t)b * LP * PLD;
    const int qrow = qb * 128 + qs * 32 + r;
    bf16x8 bq[4];
#pragma unroll
    for (int ks = 0; ks < 4; ++ks) bq[ks] = *(const bf16x8*)(Pb + (size_t)qrow * PLD + C_AQ + hd * 128 + mp * 64 + ks * 16 + h * 8);
    f32x16 ot[4];
#pragma unroll
    for (int v = 0; v < 4; ++v)
#pragma unroll
        for (int i = 0; i < 16; ++i) ot[v][i] = 0.f;
    float mrun = -INFINITY, lrun = 0.f;
    const int kt0 = (qb >= 1) ? 1 : 0, kt1 = 2 * (qb + 1);
    u32x4 pk[2], pv[2];
    const int srow = tid >> 4, sc16 = tid & 15;
    const bf16_t* gsrc = Pb + (size_t)srow * PLD + hd * 128 + sc16 * 8;
#define A_GLOAD(kt) do { _Pragma("unroll") for (int _i = 0; _i < 2; ++_i) { const bf16_t* _s = gsrc + (size_t)((kt) * 64 + 32 * _i) * PLD; \
        pk[_i] = *(const u32x4*)(_s + C_AK); pv[_i] = *(const u32x4*)(_s + C_AV); } } while (0)
#define A_LSTORE(kbuf, vbuf, ktile) do { _Pragma("unroll") for (int _i = 0; _i < 2; ++_i) { \
        if ((ktile) < 2 && (ktile) * 64 + 32 * _i + srow < PADR) { pk[_i] = (u32x4){0u, 0u, 0u, 0u}; pv[_i] = (u32x4){0u, 0u, 0u, 0u}; }     \
        *(u32x4*)(smem + (kbuf) * AK_BUF + (srow + 32 * _i) * AK_STR + sc16 * 16) = pk[_i]; \
        *(u32x4*)(smem + AV_BASE + (vbuf) * AV_BUF + (srow + 32 * _i) * AV_STR + sc16 * 16) = pv[_i]; } } while (0)
    A_GLOAD(kt0); A_LSTORE(0, 0, kt0);
    __syncthreads();
    AttnCtx c; c.r = r; c.h = h; c.mp = mp; c.qb = qb; c.qrow = qrow; c.smem = smem; c.lds0 = (unsigned)(size_t)smem;
    c.vlane = (unsigned)((4 * h + ((lane >> 2) & 3)) * AV_STR + (16 * ((lane >> 4) & 1) + 4 * (lane & 3)) * 2);
    f32x16 st[2];
    bf16x8 pf[2][2];
    int kc = 0, vc = 0, vp = 2;
    if (mp == 0) {
        for (int kt = kt0; kt < kt1; ++kt) {
            const int vn = (vc == 2) ? 0 : vc + 1;
            if (kt + 1 < kt1) A_GLOAD(kt + 1);
            attn_S(st, bq, c, kc); attn_softmax(st, pf, ot, mrun, lrun, c, kt); attn_PV(ot, pf, c, vc);
            if (kt + 1 < kt1) A_LSTORE(kc ^ 1, vn, kt + 1);
            __syncthreads();
            kc ^= 1; vp = vc; vc = vn;
        }
    } else {
        for (int kt = kt0; kt < kt1; ++kt) {
            const int vn = (vc == 2) ? 0 : vc + 1;
            if (kt + 1 < kt1) A_GLOAD(kt + 1);
            if (kt > kt0) attn_PV(ot, pf, c, vp);
            attn_S(st, bq, c, kc); attn_softmax(st, pf, ot, mrun, lrun, c, kt);
            if (kt + 1 < kt1) A_LSTORE(kc ^ 1, vn, kt + 1);
            __syncthreads();
            kc ^= 1; vp = vc; vc = vn;
        }
        attn_PV(ot, pf, c, vp);
    }
#undef A_GLOAD
#undef A_LSTORE
    const float ltot = lrun + shx(lrun, 32);
    const float inv = 1.0f / ltot;
    float* X = (float*)smem;
    __syncthreads();
    if (mp == 1) {
#pragma unroll
        for (int v = 0; v < 4; ++v)
#pragma unroll
            for (int i = 0; i < 16; ++i) X[(qs * 64 + v * 16 + i) * 64 + lane] = ot[v][i] * inv;
    }
    __syncthreads();
    if (mp == 0) {
        float ss = 0.f;
#pragma unroll
        for (int v = 0; v < 4; ++v)
#pragma unroll
            for (int i = 0; i < 16; ++i) { const float o = ot[v][i] * inv - lam * X[(qs * 64 + v * 16 + i) * 64 + lane]; ot[v][i] = o; ss += o * o; }
        ss += shx(ss, 32);
        const float rs = rsqrtf(ss * (1.0f / 128.0f) + EPS) * one_m_li;
        bf16_t* orow = OA + (size_t)(b * LP + qrow) * (2 * D) + hd * 128;
#pragma unroll
        for (int v = 0; v < 4; ++v)
#pragma unroll
            for (int g4 = 0; g4 < 4; ++g4) {
                const int vc2 = 32 * v + 8 * g4 + 4 * h;
                const f32x4 gv = *(const f32x4*)(subg + vc2);
                u32x2 w; w.x = pk2(ot[v][4 * g4] * rs * gv[0], ot[v][4 * g4 + 1] * rs * gv[1]); w.y = pk2(ot[v][4 * g4 + 2] * rs * gv[2], ot[v][4 * g4 + 3] * rs * gv[3]);
                *(u32x2*)(orow + vc2) = w;
            }
    }
    __syncthreads();
}

constexpr int RV_STR = 576, RV_BYTES = 128 * RV_STR, RKA_STR = 320, RKC_STR = 272;
DI void ret_stage_v(const bf16_t* __restrict__ Pb, int c, int h8, unsigned char* smem) {
    const int tid = opaque_tid();
#pragma unroll
    for (int i = 0; i < 8; ++i) { const int p = tid + 512 * i, row = p >> 5, c16 = p & 31;
        u32x4 w = {0u, 0u, 0u, 0u};
        if (c > 0 || row >= PADR) w = *(const u32x4*)(Pb + (size_t)(c * 128 + row) * PLD + C_RV + h8 * 256 + c16 * 8);
        *(u32x4*)(smem + row * RV_STR + c16 * 16) = w; }
}
template <int S> DI void reta_step(f32x16 (&acc)[4], unsigned va0, unsigned ka0) {
    const unsigned va = va0 + (unsigned)(16 * S * RV_STR), ka = ka0 + (unsigned)(16 * S * RKA_STR);
    const s16x4 al = tr_read<0>(va), ah = tr_read<4 * RV_STR>(va);
    const s16x4 b0l = tr_read<0>(ka), b0h = tr_read<4 * RKA_STR + 0>(ka);
    const s16x4 b1l = tr_read<64>(ka), b1h = tr_read<4 * RKA_STR + 64>(ka);
    const s16x4 b2l = tr_read<128>(ka), b2h = tr_read<4 * RKA_STR + 128>(ka);
    const s16x4 b3l = tr_read<192>(ka), b3h = tr_read<4 * RKA_STR + 192>(ka);
    LGKM0();
    const bf16x8 a = PK8(al, ah);
    acc[0] = MFMA32(a, PK8(b0l, b0h), acc[0]);
    acc[1] = MFMA32(a, PK8(b1l, b1h), acc[1]);
    acc[2] = MFMA32(a, PK8(b2l, b2h), acc[2]);
    acc[3] = MFMA32(a, PK8(b3l, b3h), acc[3]);
}
DI void reta_item(const bf16_t* __restrict__ P, float* __restrict__ KVT, int b, int h8, int c, unsigned char* smem) {
    const int tid = opaque_tid(), wid = __builtin_amdgcn_readfirstlane(tid >> 6), lane = tid & 63, r = lane & 31, h = lane >> 5;
    const bf16_t* Pb = P + (size_t)b * LP * PLD;
    const float lg2 = __log2f(1.0f - fexp2(-5.0f - (float)h8));
    ret_stage_v(Pb, c, h8, smem);
#pragma unroll
    for (int i = 0; i < 4; ++i) { const int p = tid + 512 * i, row = p >> 4, c16 = p & 15;
        u32x4 w = {0u, 0u, 0u, 0u};
        if (c > 0 || row >= PADR) w = *(const u32x4*)(Pb + (size_t)(c * 128 + row) * PLD + C_RK + h8 * 128 + c16 * 8);
        const float d = fexp2(lg2 * (float)(127 - row));
        u32x4 o;
        o.x = pk2(bf2f(w.x & 0xffffu) * d, bf2f(w.x >> 16) * d); o.y = pk2(bf2f(w.y & 0xffffu) * d, bf2f(w.y >> 16) * d);
        o.z = pk2(bf2f(w.z & 0xffffu) * d, bf2f(w.z >> 16) * d); o.w = pk2(bf2f(w.w & 0xffffu) * d, bf2f(w.w >> 16) * d);
        *(u32x4*)(smem + RV_BYTES + row * RKA_STR + c16 * 16) = o; }
    __syncthreads();
    f32x16 acc[4];
#pragma unroll
    for (int t = 0; t < 4; ++t)
#pragma unroll
        for (int i = 0; i < 16; ++i) acc[t][i] = 0.f;
    const unsigned lds0 = (unsigned)(size_t)smem;
    const int qq = (lane >> 2) & 3, pp = lane & 3, blk = (lane >> 4) & 1;
    const unsigned va = lds0 + (unsigned)((8 * h + qq) * RV_STR + (32 * wid + 16 * blk + 4 * pp) * 2);
    const unsigned ka = lds0 + RV_BYTES + (unsigned)((8 * h + qq) * RKA_STR + (16 * blk + 4 * pp) * 2);
    reta_step<0>(acc, va, ka); reta_step<1>(acc, va, ka); reta_step<2>(acc, va, ka); reta_step<3>(acc, va, ka);
    reta_step<4>(acc, va, ka); reta_step<5>(acc, va, ka); reta_step<6>(acc, va, ka); reta_step<7>(acc, va, ka);
    __syncthreads();
    float* Lw = (float*)smem + wid * 4096;
#pragma unroll
    for (int t = 0; t < 4; ++t)
#pragma unroll
        for (int i = 0; i < 16; ++i) Lw[crow(i, h) * 128 + 32 * t + r] = acc[t][i];
    asm volatile("s_waitcnt lgkmcnt(0)" ::: "memory");
    float* dst = KVT + ((size_t)((b * 8 + h8) * 16 + c)) * 32768 + (size_t)(32 * wid) * 128;
    const int orow = lane >> 5, ocol = (lane & 31) * 4;
#pragma unroll
    for (int j = 0; j < 16; ++j) st16_wt(dst + (2 * j + orow) * 128 + ocol, *(const f32x4*)(Lw + (2 * j + orow) * 128 + ocol));
    __syncthreads();
}
template <int VT> DI void retc_pv(f32x16& o, unsigned vb, const bf16x8 (&pf)[2]) {
    const s16x4 l0 = tr_read<(0) * RV_STR + VT * 64>(vb), h0 = tr_read<(8) * RV_STR + VT * 64>(vb);
    const s16x4 l1 = tr_read<(16) * RV_STR + VT * 64>(vb), h1 = tr_read<(24) * RV_STR + VT * 64>(vb);
    LGKM0();
    o = MFMA32(PK8(l0, h0), pf[0], o);
    o = MFMA32(PK8(l1, h1), pf[1], o);
}
DI void retc_item(const bf16_t* __restrict__ P, const bf16_t* __restrict__ PREVT, bf16_t* __restrict__ OR_, const float* __restrict__ gng,
                  int b, int h8, int c, unsigned char* smem) {
    const int tid = opaque_tid(), wid = __builtin_amdgcn_readfirstlane(tid >> 6), lane = tid & 63, r = lane & 31, h = lane >> 5;
    const int nb = wid & 3, dh = wid >> 2;
    const bf16_t* Pb = P + (size_t)b * LP * PLD;
    const float lg2 = __log2f(1.0f - fexp2(-5.0f - (float)h8));
    u32x4 rv[8], rk[4];
#pragma unroll
    for (int i = 0; i < 8; ++i) { const int p = tid + 512 * i, row = p >> 5, c16 = p & 31;
        rv[i] = (u32x4){0u, 0u, 0u, 0u};
        if (c > 0 || row >= PADR) rv[i] = *(const u32x4*)(Pb + (size_t)(c * 128 + row) * PLD + C_RV + h8 * 256 + c16 * 8); }
#pragma unroll
    for (int i = 0; i < 4; ++i) { const int p = tid + 512 * i, row = p >> 4, c16 = p & 15;
        rk[i] = (u32x4){0u, 0u, 0u, 0u};
        if (c > 0 || row >= PADR) rk[i] = *(const u32x4*)(Pb + (size_t)(c * 128 + row) * PLD + C_RK + h8 * 128 + c16 * 8); }
    const int nloc = 32 * nb + r;
    const int grow = b * LP + c * 128 + nloc;
    bf16x8 bq[8];
#pragma unroll
    for (int ks = 0; ks < 8; ++ks) bq[ks] = *(const bf16x8*)(P + (size_t)grow * PLD + C_RQ + h8 * 128 + ks * 16 + h * 8);
    f32x16 acc[4];
    const bf16_t* pv = PREVT + ((size_t)((b * 8 + h8) * 17 + c)) * 32768 + (size_t)(128 * dh + r) * 128 + h * 8;
    bf16x8 pa[2][8];
#pragma unroll
    for (int ks = 0; ks < 8; ++ks) pa[0][ks] = *(const bf16x8*)(pv + ks * 16);
#pragma unroll
    for (int v = 0; v < 4; ++v) {
        if (v + 1 < 4) {
#pragma unroll
            for (int ks = 0; ks < 8; ++ks) pa[(v + 1) & 1][ks] = *(const bf16x8*)(pv + (size_t)(32 * (v + 1)) * 128 + ks * 16);
        }
#pragma unroll
        for (int i = 0; i < 16; ++i) acc[v][i] = 0.f;
#pragma unroll
        for (int ks = 0; ks < 8; ++ks) acc[v] = MFMA32(pa[v & 1][ks], bq[ks], acc[v]);
    }
#pragma unroll
    for (int i = 0; i < 8; ++i) { const int p = tid + 512 * i, row = p >> 5, c16 = p & 31; *(u32x4*)(smem + row * RV_STR + c16 * 16) = rv[i]; }
#pragma unroll
    for (int i = 0; i < 4; ++i) { const int p = tid + 512 * i, row = p >> 4, c16 = p & 15; *(u32x4*)(smem + RV_BYTES + row * RKC_STR + c16 * 16) = rk[i]; }
    __syncthreads();
    const float dq = fexp2(lg2 * (float)(nloc + 1));
#pragma unroll
    for (int v = 0; v < 4; ++v)
#pragma unroll
        for (int i = 0; i < 16; ++i) acc[v][i] *= dq;
    const unsigned lds0 = (unsigned)(size_t)smem;
    const int qq = (lane >> 2) & 3, pp = lane & 3, blk = (lane >> 4) & 1;
    for (int mt = 0; mt <= nb; ++mt) {
        f32x16 st;
#pragma unroll
        for (int i = 0; i < 16; ++i) st[i] = 0.f;
#pragma unroll
        for (int ks = 0; ks < 8; ++ks) {
            const bf16x8 a = *(const bf16x8*)(smem + RV_BYTES + (32 * mt + r) * RKC_STR + (ks * 16 + h * 8) * 2);
            st = MFMA32(a, bq[ks], st);
        }
#pragma unroll
        for (int i = 0; i < 16; ++i) { const int dd = nloc - (32 * mt + crow(i, h)); st[i] = (dd >= 0) ? st[i] * fexp2(lg2 * (float)dd) : 0.f; }
        bf16x8 pf[2];
        pf[0] = pack8(st[0], st[1], st[2], st[3], st[4], st[5], st[6], st[7]);
        pf[1] = pack8(st[8], st[9], st[10], st[11], st[12], st[13], st[14], st[15]);
        const unsigned vb = lds0 + (unsigned)((32 * mt + 4 * h + qq) * RV_STR + (128 * dh + 16 * blk + 4 * pp) * 2);
        retc_pv<0>(acc[0], vb, pf); retc_pv<1>(acc[1], vb, pf); retc_pv<2>(acc[2], vb, pf); retc_pv<3>(acc[3], vb, pf);
    }
    float s1 = 0.f, s2 = 0.f;
#pragma unroll
    for (int v = 0; v < 4; ++v)
#pragma unroll
        for (int i = 0; i < 16; ++i) { s1 += acc[v][i]; s2 += acc[v][i] * acc[v][i]; }
    s1 += shx(s1, 32); s2 += shx(s2, 32);
    float* ST = (float*)(smem + RV_BYTES + 128 * RKC_STR);
    if (h == 0) { ST[(dh * 128 + nloc) * 2] = s1; ST[(dh * 128 + nloc) * 2 + 1] = s2; }
    __syncthreads();
    const float t1 = ST[nloc * 2] + ST[(128 + nloc) * 2], t2 = ST[nloc * 2 + 1] + ST[(128 + nloc) * 2 + 1];
    const float mu = t1 * (1.0f / 256.0f);
    const float var = fmaxf(t2 * (1.0f / 256.0f) - mu * mu, 0.f);
    const float rstd = rsqrtf(var + EPS);
#pragma unroll
    for (int v = 0; v < 4; ++v)
#pragma unroll
        for (int g4 = 0; g4 < 4; ++g4) {
            const int col = h8 * 256 + 128 * dh + 32 * v + 8 * g4 + 4 * h;
            const f32x4 gv = *(const f32x4*)(gng + col);
            const u32x2 sw = *(const u32x2*)(P + (size_t)grow * PLD + C_RG + col);
            const float y0 = (acc[v][4 * g4] - mu) * rstd * gv[0] * bf2f(sw.x & 0xffffu);
            const float y1 = (acc[v][4 * g4 + 1] - mu) * rstd * gv[1] * bf2f(sw.x >> 16);
            const float y2 = (acc[v][4 * g4 + 2] - mu) * rstd * gv[2] * bf2f(sw.y & 0xffffu);
            const float y3 = (acc[v][4 * g4 + 3] - mu) * rstd * gv[3] * bf2f(sw.y >> 16);
            u32x2 w; w.x = pk2(y0, y1); w.y = pk2(y2, y3);
            *(u32x2*)(OR_ + (size_t)grow * (2 * D) + col) = w;
        }
    __syncthreads();
}

__global__ void __launch_bounds__(512, 2) fwd_megakernel(Params prm) {
    extern __shared__ __attribute__((aligned(16))) unsigned char smem[];
    cg::grid_group grid = cg::this_grid();
    unsigned epoch = 0;
    unsigned char* ws = prm.ws;
#define WSP(T, OFF) ((T*)(wsl(ws) + (OFF)))
#define BAR WSP(unsigned, WS_BAR)
#define GSYNC() xcd_barrier(xb)
    const int tid = threadIdx.x, wid = tid >> 6, lane = tid & 63;
#define LAM WSP(float, WS_LAM)
#define TA WSP(float, WS_TA)
#define TR WSP(float, WS_TR)
#define HF WSP(float, WS_HF)
#define HB WSP(bf16_t, WS_HB)
#define P WSP(bf16_t, WS_P)
#define U WSP(bf16_t, WS_P)
#define OA WSP(bf16_t, WS_OA)
#define OR_ (WSP(bf16_t, WS_OA) + D)
#define MG WSP(bf16_t, WS_MG)
#define PREVT WSP(bf16_t, WS_MG)
#define ACT WSP(bf16_t, WS_ACT)
#define KVT WSP(float, WS_ACT)
    LAS unsigned char* lds = (LAS unsigned char*)smem;
    volatile LAS unsigned* xst = (volatile LAS unsigned*)(lds + LDS_MISC + 16);
    if (threadIdx.x == 0) { xst[0] = 0u; xst[1] = 0u; }
    __syncthreads();
    const XcdBarrier xb = xcd_barrier_post((unsigned*)(prm.ws + WS_XB), xst);
    const int gw = blockIdx.x * 8 + wid, nw = gridDim.x * 8;

    transpose_convert<true>(prm.in[4], (bf16_t*)(ws + WS_WIN), D, WIN);
    for (int i = blockIdx.x * 512 + tid; i < LP * 96; i += gridDim.x * 512) {
        const int l = i / 96, j = i % 96; const float pos = (float)(l - PADR);
        float f; float* dst;
        if (j < 32) { f = 1.0f / powf(10000.0f, (float)(2 * j) / 64.0f); dst = TA + ((size_t)l * 32 + j) * 2; }
        else { const int jj = j - 32; f = 1.0f / powf(10000.0f, (float)jj / 63.0f); dst = TR + ((size_t)l * 64 + jj) * 2; }
        const float ang = pos * f;
        dst[0] = (float)cos((double)ang); dst[1] = (float)sin((double)ang);
    }
    if (tid < 23) ((const float**)(ws + WS_TAB))[tid] = (tid < 22) ? prm.in[tid] : (const float*)prm.out;
    if (blockIdx.x == 0 && tid < 2) {
        const int l = tid; float s1 = 0.f, s2 = 0.f;
        for (int i = 0; i < 64; ++i) { s1 += prm.in[5][l * 64 + i] * prm.in[6][l * 64 + i]; s2 += prm.in[7][l * 64 + i] * prm.in[8][l * 64 + i]; }
        const float li = 0.8f - 0.6f * expf(-0.3f * (float)l);
        LAM[l] = expf(s1) - expf(s2) + li;
    }
    for (int row = gw; row < MROWS; row += nw) {
        const int b = row / LP, l = row % LP;
        if (l < PADR) continue;
        f32x4 x[8];
        {
            const float* src = (l < 128) ? prm.in[1] + (size_t)(l - PADR) * D : prm.in[0] + ((size_t)b * SEQ + (l - 128)) * D;
#pragma unroll
            for (int j = 0; j < 8; ++j) x[j] = *(const f32x4*)(src + (j * 64 + lane) * 4);
        }
        ln_row(x, prm.in[2], prm.in[3], lane);
        store_h(x, HF, HB, row, lane);
    }
    grid.sync();

#pragma nounroll
    for (int layer = 0; layer < 2; ++layer) {
        const float lam_init = 0.8f - 0.6f * expf(-0.3f * (float)layer);
        for (int rep = 0; rep < REP_INPROJ; ++rep)
        {
            pg8::Gemm g{HB, (const bf16_t*)(ws + WS_WIN + layer * SZ_WIN), MROWS, WIN, D};
            pg8::StaticOrder S; S.init(NB * SEQ, WIN, gridDim.x, blockIdx.x);
            EpiIn E{P, TA, TR};
            pg8::gemm_phase(lds, g, S, E);
            meta_gemm(g.A, g.Bt, WIN, D, E, smem);
        }
        GSYNC();
        for (int rep = 0; rep < REP_ATTN; ++rep)
        {
            const float lam = LAM[layer];
            volatile int* sidx = (volatile int*)(smem + LDS_MISC);
            const int qt = opaque_tid();
            const int grp = blockIdx.x & 7;
            unsigned* qbase = (unsigned*)(ws + WS_QCTR);
            unsigned* qctr = qbase + 16 * (layer * 8 + grp) + 256 * rep;
            unsigned* pa_done = qbase + 512 + layer * 32;
            unsigned* sc_done = qbase + 576 + layer * 32;
            for (;;) {
                if (qt == 0) *sidx = (int)atomicAdd(qctr, 1u);
                __syncthreads();
                const int idx = __builtin_amdgcn_readfirstlane(*sidx);
                __syncthreads();
                const int NC = (layer == 0) ? ((CT_ITEMS - grp + 7) >> 3) : 0;
                if (idx >= 300 + NC) break;
                if (idx < 64) {
                    const int bh = grp + 8 * (idx >> 4), c = idx & 15;
                    reta_item(P, KVT, bh >> 3, bh & 7, c, smem);
                    item_signal_wt(pa_done + bh);
                } else if (idx < 96) {
                    const int j = idx - 64, bh = grp + 8 * (j >> 3), part = j & 7, h8 = bh & 7;
                    item_wait(pa_done + bh, 16u);
                    const int off = part * 4096 + qt * 8;
                    const float cd = fexp2(128.0f * __log2f(1.0f - fexp2(-5.0f - (float)h8)));
                    float sst[8]; float zz = 0.f; asm volatile("" : "+v"(zz));
#pragma unroll
                    for (int e = 0; e < 8; ++e) sst[e] = zz;
#pragma unroll 4
                    for (int c = 0; c < 17; ++c) {
                        u32x4 w; w.x = pk2(sst[0], sst[1]); w.y = pk2(sst[2], sst[3]); w.z = pk2(sst[4], sst[5]); w.w = pk2(sst[6], sst[7]);
                        st16_wt(PREVT + ((size_t)(bh * 17 + c)) * 32768 + off, w);
                        if (c < 16) {
                            const float* kp = KVT + ((size_t)(bh * 16 + c)) * 32768 + off;
                            const f32x4 k0 = *(const f32x4*)kp, k1 = *(const f32x4*)(kp + 4);
#pragma unroll
                            for (int e = 0; e < 4; ++e) { sst[e] = cd * sst[e] + k0[e]; sst[4 + e] = cd * sst[4 + e] + k1[e]; }
                        }
                    }
                    item_signal_wt(sc_done + bh);
                } else if (idx < 232 + NC) {
                    const int p = idx - 96;
                    int ai = -1, ci = -1;
                    if (p < 3 * NC) { if (p % 3 == 2) ci = p / 3; else ai = p - p / 3; } else ai = p - NC;
                    if (ai >= 136) { ci = NC - 1 - (ai - 136); ai = -1; }
                    if (ci >= 0) {
                        const int item = grp + 8 * ci;
                        convert_deferred_item(ws, item);
                    } else {
                        const int bh = grp + 8 * (ai / 17), qb = 16 - (ai % 17);
                        attn_item(P, OA, argp(ws, 9) + layer * 128, lam, 1.0f - lam_init, bh >> 4, bh & 15, qb, smem);
                    }
                } else {
                    const int j = idx - 232 - NC; const int bh = grp + 8 * (j / 17), c = j % 17;
                    item_wait(sc_done + bh, 8u);
                    retc_item(P, PREVT, OR_, argp(ws, 10) + layer * D, bh >> 3, bh & 7, c, smem);
                }
            }
        }
        GSYNC();
        {
            pg8::StaticOrder S; S.init(NB * SEQ, D, gridDim.x, blockIdx.x);
            pg8::Gemm g{OA, (const bf16_t*)(ws + WS_WA + layer * 2 * SZ_SQ), MROWS, D, 2 * D};
            EpiMerge E{P, MG};
            pg8::gemm_phase(lds, g, S, E);
            meta_gemm_merge(g.A, g.Bt, E, smem);
        }
        GSYNC();
        {
            pg8::StaticOrder S; S.init(NB * SEQ, D, gridDim.x, blockIdx.x);
            pg8::Gemm g{MG, (const bf16_t*)(ws + WS_WO + layer * SZ_SQ), MROWS, D, D};
            EpiLN E{HF, HB, nullptr, argp(ws, 14) + layer * D, argp(ws, 15) + layer * D, (float*)(ws + WS_STATS), (unsigned*)(ws + WS_LNCNT) + (layer * 2 + 0) * 64, smem};
            pg8::gemm_phase(lds, g, S, E);
            meta_gemm_ln(g.A, g.Bt, D, E, smem);
        }
        GSYNC();
        {
            pg8::StaticOrder S; S.init(NB * SEQ, DFF2, gridDim.x, blockIdx.x);
            pg8::Gemm g{HB, (const bf16_t*)(ws + WS_WUP + layer * SZ_WUP), MROWS, DFF2, D};
            EpiUp E{U};
            pg8::gemm_phase(lds, g, S, E);
            meta_gemm(g.A, g.Bt, DFF2, D, E, smem);
        }
        GSYNC();
        for (int rep = 0; rep < REP_MISC; ++rep)
        {
            const float* cw = argp(ws, 17) + (size_t)layer * 3 * DFF2; const float* cb = argp(ws, 18) + (size_t)layer * DFF2;
            const int ctid = opaque_tid();
            for (int idx = blockIdx.x * 512 + ctid; idx < NB * 129 * (DFF / 8); idx += gridDim.x * 512) {
                const int rbi = idx / (DFF / 8), j = (idx % (DFF / 8)) * 8;
                const int b = rbi / 129, l0 = PADR + (rbi % 129) * 16;
                const bf16_t* up = U + (size_t)(b * LP + l0) * DFF2 + j;
                float w[2][3][8], bs[2][8];
#pragma unroll
                for (int q = 0; q < 2; ++q) {
#pragma unroll
                    for (int t = 0; t < 3; ++t) { const f32x4 a0 = *(const f32x4*)(cw + (size_t)t * DFF2 + q * DFF + j), a1 = *(const f32x4*)(cw + (size_t)t * DFF2 + q * DFF + j + 4);
#pragma unroll
                        for (int e = 0; e < 4; ++e) { w[q][t][e] = a0[e]; w[q][t][4 + e] = a1[e]; } }
                    const f32x4 c0 = *(const f32x4*)(cb + q * DFF + j), c1 = *(const f32x4*)(cb + q * DFF + j + 4);
#pragma unroll
                    for (int e = 0; e < 4; ++e) { bs[q][e] = c0[e]; bs[q][4 + e] = c1[e]; }
                }
                u32x4 h2[2], h1[2];
#pragma unroll
                for (int q = 0; q < 2; ++q) {
                    h2[q] = (u32x4){0u, 0u, 0u, 0u}; h1[q] = (u32x4){0u, 0u, 0u, 0u};
                    if (l0 > PADR) { h2[q] = *(const u32x4*)(up - 2 * (size_t)DFF2 + q * DFF); h1[q] = *(const u32x4*)(up - (size_t)DFF2 + q * DFF); }
                }
#pragma unroll 4
                for (int t = 0; t < 16; ++t) {
                    u32x4 h0[2];
#pragma unroll
                    for (int q = 0; q < 2; ++q) h0[q] = *(const u32x4*)(up + (size_t)t * DFF2 + q * DFF);
                    float c[2][8];
#pragma unroll
                    for (int q = 0; q < 2; ++q) {
#pragma unroll
                        for (int e2 = 0; e2 < 4; ++e2) {
                            const unsigned x2 = h2[q][e2], x1 = h1[q][e2], x0 = h0[q][e2];
                            c[q][2 * e2] = bs[q][2 * e2] + w[q][0][2 * e2] * bf2f(x2 & 0xffffu) + w[q][1][2 * e2] * bf2f(x1 & 0xffffu) + w[q][2][2 * e2] * bf2f(x0 & 0xffffu);
                            c[q][2 * e2 + 1] = bs[q][2 * e2 + 1] + w[q][0][2 * e2 + 1] * bf2f(x2 >> 16) + w[q][1][2 * e2 + 1] * bf2f(x1 >> 16) + w[q][2][2 * e2 + 1] * bf2f(x0 >> 16);
                        }
                        h2[q] = h1[q]; h1[q] = h0[q];
                    }
                    float a[8];
#pragma unroll
                    for (int e = 0; e < 8; e += 2) { const f32x2 gg = gelu_pk((f32x2){c[0][e], c[0][e + 1]}); a[e] = gg.x * c[1][e]; a[e + 1] = gg.y * c[1][e + 1]; }
                    u32x4 o; o.x = pk2(a[0], a[1]); o.y = pk2(a[2], a[3]); o.z = pk2(a[4], a[5]); o.w = pk2(a[6], a[7]);
                    *(u32x4*)(ACT + (size_t)(b * LP + l0 + t) * DFF + j) = o;
                }
            }
        }
        GSYNC();
        {
            pg8::StaticOrder S; S.init(NB * SEQ, D, gridDim.x, blockIdx.x);
            pg8::Gemm g{ACT, (const bf16_t*)(ws + WS_WDN + layer * SZ_WDN), MROWS, D, DFF};
            EpiLN E{HF, HB, (layer == 1) ? (float*)argp(ws, 22) : nullptr, argp(ws, 20) + layer * D, argp(ws, 21) + layer * D, (float*)(ws + WS_STATS), (unsigned*)(ws + WS_LNCNT) + (layer * 2 + 1) * 64, smem};
            pg8::gemm_phase(lds, g, S, E);
            if (layer == 0) meta_gemm_ln(g.A, g.Bt, DFF, E, smem);
        }
        if (layer == 0) GSYNC();
    }
}

extern "C" void kernel_launch(void* const* d_in, const int* in_sizes, int n_in, void* d_out, int out_size, void* d_ws, size_t ws_size, hipStream_t stream) {
    static int grid_blocks = 0;
    if (!grid_blocks) {
        if (n_in != 22 || ws_size < WS_END) { fprintf(stderr, "kernel_launch: unexpected n_in %d or ws %zu < %zu\n", n_in, ws_size, (size_t)WS_END); grid_blocks = -1; return; }
        int dev = 0, cus = 0, per_cu = 0;
        hipGetDevice(&dev);
        hipDeviceGetAttribute(&cus, hipDeviceAttributeMultiprocessorCount, dev);
        if (hipFuncSetAttribute((const void*)fwd_megakernel, hipFuncAttributeMaxDynamicSharedMemorySize, LDS_BYTES) != hipSuccess) fprintf(stderr, "kernel_launch: hipFuncSetAttribute failed\n");
        if (hipOccupancyMaxActiveBlocksPerMultiprocessor(&per_cu, (const void*)fwd_megakernel, 512, LDS_BYTES) != hipSuccess || per_cu < 1) { fprintf(stderr, "kernel_launch: occupancy query gave %d\n", per_cu); per_cu = 1; }
        (void)hipGetLastError();
        grid_blocks = cus * (per_cu > 1 ? 1 : per_cu);
        if (grid_blocks > 256) grid_blocks = 256;
        if (grid_blocks != 256) { fprintf(stderr, "kernel_launch: this kernel needs exactly 256 resident workgroups (got %d); nothing launched\n", grid_blocks); grid_blocks = -1; return; }
    }
    if (grid_blocks < 0) return;
    (void)hipMemsetAsync((char*)d_ws + WS_CTR, 0, WS_TA, stream);
    Params p{};
    for (int i = 0; i < 22; ++i) p.in[i] = (const float*)d_in[i];
    p.out = (float*)d_out; p.ws = (unsigned char*)d_ws;
    void* args[] = {&p};
    hipError_t e = hipLaunchCooperativeKernel((const void*)fwd_megakernel, dim3(grid_blocks), dim3(512), args, LDS_BYTES, stream);
    if (e != hipSuccess) fprintf(stderr, "cooperative launch failed: %s (grid %d)\n", hipGetErrorString(e), grid_blocks);
}
```

```cpp
#include <hip/hip_runtime.h>
#include <hip/hip_cooperative_groups.h>
#include <cstdio>
namespace cg = cooperative_groups;

#define LAS __attribute__((address_space(3)))
#define DI __device__ __forceinline__
typedef unsigned short bf16_t;
typedef short bf16x8 __attribute__((ext_vector_type(8)));
typedef short s16x4 __attribute__((ext_vector_type(4)));
typedef float f32x2 __attribute__((ext_vector_type(2)));
typedef float f32x4 __attribute__((ext_vector_type(4)));
typedef float f32x16 __attribute__((ext_vector_type(16)));
typedef unsigned u32x2 __attribute__((ext_vector_type(2)));
typedef unsigned u32x4 __attribute__((ext_vector_type(4)));
typedef __bf16 bf2_t __attribute__((ext_vector_type(2)));

constexpr int D = 2048, NB = 4, LP = 2176, MROWS = NB * LP, PADR = 112, SEQ = 2048;
constexpr int WIN = 16384, DFF = 5504, DFF2 = 11008;
constexpr int PLD = WIN + 128;
constexpr float ALPHA = 1.41421356237f, EPS = 1e-5f;
constexpr int C_AQ = 0, C_AK = 2048, C_AV = 4096, C_RQ = 6144, C_RK = 7168, C_RV = 8192, C_RG = 10240, C_GA = 12288, C_GB = 14336;

constexpr size_t WS_CTR = 0;
constexpr size_t WS_LAM = 256;
constexpr size_t WS_BAR = 512;
constexpr size_t WS_QCTR = 512 + 5120;
constexpr size_t WS_LNCNT = 512 + 8192;
constexpr size_t WS_TAB = 512 + 8192 + 2048;
constexpr size_t WS_XB = 512 + 16384;
constexpr size_t WS_TA = 512 + 16384 + 16384;
constexpr size_t WS_TR = WS_TA + (size_t)LP * 32 * 2 * 4;
constexpr size_t WS_WIN = WS_TR + (size_t)LP * 64 * 2 * 4;
constexpr size_t SZ_WIN = (size_t)WIN * D * 2;
constexpr size_t WS_WA = WS_WIN + 2 * SZ_WIN;
constexpr size_t SZ_SQ = (size_t)D * D * 2;
constexpr size_t WS_WB = WS_WA + 2 * SZ_SQ;
constexpr size_t WS_WO = WS_WB + 2 * SZ_SQ;
constexpr size_t WS_WUP = WS_WO + 2 * SZ_SQ;
constexpr size_t SZ_WUP = (size_t)DFF2 * D * 2;
constexpr size_t WS_WDN = WS_WUP + 2 * SZ_WUP;
constexpr size_t SZ_WDN = (size_t)D * DFF * 2;
constexpr size_t WS_HF = WS_WDN + 2 * SZ_WDN;
constexpr size_t WS_HB = WS_HF + (size_t)MROWS * D * 4;
constexpr size_t WS_P = WS_HB + (size_t)MROWS * D * 2;
constexpr size_t WS_OA = WS_P + (size_t)MROWS * PLD * 2;
constexpr size_t WS_OR = WS_OA + (size_t)MROWS * D * 2;
constexpr size_t WS_MG = WS_OR + (size_t)MROWS * D * 2;
constexpr size_t WS_PRE = WS_MG + (size_t)MROWS * D * 2;
constexpr size_t WS_ACT = WS_PRE + (size_t)MROWS * D * 4;
constexpr size_t WS_STATS = WS_ACT + (size_t)MROWS * DFF * 2;
constexpr size_t WS_END = WS_STATS + (size_t)(32 * 8 * 256 + 64 * 16) * 8;

#define REP_P0 1
#define REP_INPROJ 1
#define REP_ATTN 1
#define REP_MISC 1
#ifndef PMASK
#define PMASK 0xffff
#endif
constexpr int LDS_BYTES = 131072 + 1024;
constexpr int LDS_MISC = 131072;

struct Params { const float* in[22]; float* out; unsigned char* ws; };

DI int opaque_tid() { int t = threadIdx.x; asm volatile("" : "+v"(t)); return t; }
DI float shx(float v, int mask) { const int l = opaque_tid() & 63; return __int_as_float(__builtin_amdgcn_ds_bpermute((l ^ mask) << 2, __float_as_int(v))); }
DI float bf2f(unsigned h) { return __uint_as_float(h << 16); }
DI unsigned pk2(float lo, float hi) { f32x2 v = {lo, hi}; bf2_t b = __builtin_convertvector(v, bf2_t); return __builtin_bit_cast(unsigned, b); }
DI bf16_t f2bf(float x) { return (bf16_t)(pk2(x, 0.f) & 0xffffu); }
DI float wave_sum(float v) { for (int o = 32; o; o >>= 1) v += shx(v, o); return v; }
DI int crow(int i, int h) { return (i & 3) + 8 * (i >> 2) + 4 * h; }
DI float fexp2(float x) { return __builtin_amdgcn_exp2f(x); }
DI float sigmoidf_(float x) { return __builtin_amdgcn_rcpf(1.0f + fexp2(-1.4426950408889634f * x)); }
#define MFMA32(a, b, c) __builtin_amdgcn_mfma_f32_32x32x16_bf16((a), (b), (c), 0, 0, 0)
template <int OFF> DI s16x4 tr_read(unsigned addr) { s16x4 r; asm volatile("ds_read_b64_tr_b16 %0, %1 offset:%2" : "=&v"(r) : "v"(addr), "i"(OFF) : "memory"); return r; }
#define LGKM0() do { asm volatile("s_waitcnt lgkmcnt(0)" ::: "memory"); __builtin_amdgcn_sched_barrier(0); } while (0)
#define PK8(L, H) (bf16x8){L[0], L[1], L[2], L[3], H[0], H[1], H[2], H[3]}
DI bf16x8 pack8(float a0, float a1, float a2, float a3, float a4, float a5, float a6, float a7) {
    u32x4 w; w.x = pk2(a0, a1); w.y = pk2(a2, a3); w.z = pk2(a4, a5); w.w = pk2(a6, a7); return __builtin_bit_cast(bf16x8, w);
}


DI unsigned ab_ld(unsigned* p) { return __hip_atomic_load(p, __ATOMIC_RELAXED, __HIP_MEMORY_SCOPE_AGENT); }
DI unsigned ab_add(unsigned* p, unsigned v) { return __hip_atomic_fetch_add(p, v, __ATOMIC_RELAXED, __HIP_MEMORY_SCOPE_AGENT); }
#define AB_SPIN(cond) do { unsigned _sp = 0; while (cond) { __builtin_amdgcn_s_sleep(1); if (++_sp > (1u << 24)) break; } } while (0)
DI void fast_barrier(unsigned* bar, unsigned epoch) {
    asm volatile("s_waitcnt vmcnt(0)" ::: "memory");
    __syncthreads();
    if (threadIdx.x == 0) {
        const unsigned G = gridDim.x, g = blockIdx.x & 7u, ng = (G - g + 7u) >> 3, ngroups = G < 8u ? G : 8u;
        __builtin_amdgcn_fence(__ATOMIC_RELEASE, "agent");
        asm volatile("s_waitcnt vmcnt(0)" ::: "memory");
        unsigned* sub = bar + 64 * (1 + g); unsigned* gen = bar + 64 * (9 + g); unsigned* top = bar + 64 * 17; unsigned* topgen = bar + 64 * 18;
        const unsigned old = ab_add(sub, 1u);
        if (old + 1u == epoch * ng) {
            const unsigned ot = ab_add(top, 1u);
            if (ot + 1u == epoch * ngroups) ab_add(topgen, 1u);
            else AB_SPIN(ab_ld(topgen) < epoch);
            ab_add(gen, 1u);
        } else {
            AB_SPIN(ab_ld(gen) < epoch);
        }
        __builtin_amdgcn_fence(__ATOMIC_ACQUIRE, "agent");
        asm volatile("s_waitcnt vmcnt(0)" ::: "memory");
    }
    __syncthreads();
}

#define GAS __attribute__((address_space(1)))
DI unsigned char* wsl(unsigned char* ws) { GAS unsigned char* g = (GAS unsigned char*)ws; asm volatile("" : "+s"(g)); return (unsigned char*)g; }
DI const float* argp(unsigned char* ws, int i) {
    GAS const unsigned long long* t = (GAS const unsigned long long*)(ws + WS_TAB);
    asm volatile("" : "+s"(t));
    GAS const float* p = (GAS const float*)t[i];
    return (const float*)p;
}

DI f32x2 gelu_pk(f32x2 v) {
    const f32x2 av = __builtin_elementwise_abs(v), d = av * 0.2316418882f + 1.0f;
    f32x2 t; t.x = __builtin_amdgcn_rcpf(d.x); t.y = __builtin_amdgcn_rcpf(d.y);
    f32x2 q = t * 0.5307027145f + (-0.7265760135f); q = q * t + 0.7107068705f; q = q * t + (-0.142248368f); q = q * t + 0.127414796f; q = q * t;
    const f32x2 s = (v * v) * (-0.72134752044f);
    f32x2 e; e.x = __builtin_amdgcn_exp2f(s.x); e.y = __builtin_amdgcn_exp2f(s.y);
    const f32x2 m = v * (q * e), r = v - m;
    f32x2 o; o.x = v.x < 0.f ? m.x : r.x; o.y = v.y < 0.f ? m.y : r.y; return o;
}

#define XB_TMO      128
#define XB_XCNT(j)  (256  + 64 * (j))
#define XB_XSUB(j)  (1280 + 64 * (j))
#define XB_XGEN(j)  (2304 + 64 * (j))
#define XB_TOP      3328
#define XB_TOPGEN   3392
#define XB_SPIN_CAP (1u << 22)
DI unsigned xb_xcc_id() { return (unsigned)__builtin_amdgcn_s_getreg((3 << 11) | 20) & 0xFu; }
#define XB_SPIN(cond, bar) do { unsigned _sp = 0; while (cond) { __builtin_amdgcn_s_sleep(1); \
    if ((++_sp & 255u) == 0u) { if (ab_ld(&(bar)[XB_TMO])) break; if (_sp > XB_SPIN_CAP) { atomicAdd(&(bar)[XB_TMO], 1u); break; } } } } while (0)
struct XcdBarrier { unsigned* bar; unsigned x; volatile LAS unsigned* st; };
DI XcdBarrier xcd_barrier_post(unsigned* bar, volatile LAS unsigned* st) {
    XcdBarrier b; b.bar = bar; b.x = xb_xcc_id(); b.st = st;
    if (threadIdx.x == 0) (void)ab_add(&bar[XB_XCNT(b.x)], 1u);
    return b;
}
DI void xcd_barrier_complete(unsigned* bar, unsigned x, unsigned& nloc, unsigned& nx) {
    const unsigned G = gridDim.x;
    unsigned sum, cnt, mine, sp = 0u;
    for (;;) {
        sum = 0u; cnt = 0u; mine = 0u;
#pragma unroll
        for (unsigned j = 0; j < 16; ++j) { const unsigned c = ab_ld(&bar[XB_XCNT(j)]); sum += c; cnt += (c > 0u) ? 1u : 0u; mine = (j == x) ? c : mine; }
        if (sum == G) break;
        __builtin_amdgcn_s_sleep(1);
        if ((++sp & 255u) == 0u) { if (ab_ld(&bar[XB_TMO])) break; if (sp > XB_SPIN_CAP) { atomicAdd(&bar[XB_TMO], 1u); break; } }
    }
    nloc = mine > 0u ? mine : 1u; nx = cnt > 0u ? cnt : 1u;
}
DI void xcd_barrier(const XcdBarrier& b) {
    asm volatile("s_waitcnt vmcnt(0)" ::: "memory");
    __syncthreads();
    if (threadIdx.x == 0) {
        unsigned* bar = b.bar;
        __builtin_amdgcn_s_waitcnt(0);
        unsigned nloc = b.st[0], nx = b.st[1];
        if (nloc == 0u) { xcd_barrier_complete(bar, b.x, nloc, nx); b.st[0] = nloc; b.st[1] = nx; }
        const unsigned old = ab_add(&bar[XB_XSUB(b.x)], 1u);
        const unsigned gen = old / nloc;
        if (old + 1u == (gen + 1u) * nloc) {
            __builtin_amdgcn_fence(__ATOMIC_RELEASE, "agent");
            asm volatile("s_waitcnt vmcnt(0)" ::: "memory");
            const unsigned og = ab_add(&bar[XB_TOP], 1u);
            const unsigned tg = og / nx;
            if (og + 1u == (tg + 1u) * nx) ab_add(&bar[XB_TOPGEN], 1u);
            else XB_SPIN(ab_ld(&bar[XB_TOPGEN]) == tg, bar);
            __builtin_amdgcn_fence(__ATOMIC_ACQUIRE, "agent");
            ab_add(&bar[XB_XGEN(b.x)], 1u);
            asm volatile("s_waitcnt vmcnt(0)" ::: "memory");
        } else {
            XB_SPIN(ab_ld(&bar[XB_XGEN(b.x)]) == gen, bar);
            __builtin_amdgcn_fence(__ATOMIC_ACQUIRE, "agent");
            asm volatile("s_waitcnt vmcnt(0)" ::: "memory");
        }
    }
    __syncthreads();
}

DI void item_signal(unsigned* ctr) {
    asm volatile("s_waitcnt vmcnt(0)" ::: "memory");
    __syncthreads();
    if (threadIdx.x == 0) { __builtin_amdgcn_fence(__ATOMIC_RELEASE, "agent"); asm volatile("s_waitcnt vmcnt(0)" ::: "memory"); ab_add(ctr, 1u); }
}
DI void item_wait(unsigned* ctr, unsigned target) {
    if (threadIdx.x == 0) { AB_SPIN(ab_ld(ctr) < target); __builtin_amdgcn_fence(__ATOMIC_ACQUIRE, "agent"); asm volatile("s_waitcnt vmcnt(0)" ::: "memory"); }
    __syncthreads();
}

DI void st16_wt(void* p, f32x4 v) { asm volatile("s_nop 1\n\tglobal_store_dwordx4 %0, %1, off sc1\n\ts_nop 1" :: "v"(p), "v"(v) : "memory"); }
DI void st16_wt(void* p, u32x4 v) { asm volatile("s_nop 1\n\tglobal_store_dwordx4 %0, %1, off sc1\n\ts_nop 1" :: "v"(p), "v"(v) : "memory"); }
DI void st8_wt(void* p, f32x2 v) { __hip_atomic_store((unsigned long long*)p, __builtin_bit_cast(unsigned long long, v), __ATOMIC_RELAXED, __HIP_MEMORY_SCOPE_AGENT); }
DI void item_signal_wt(unsigned* ctr) {
    asm volatile("s_waitcnt vmcnt(0)" ::: "memory");
    __syncthreads();
    if (threadIdx.x == 0) ab_add(ctr, 1u);
}

DI int rowbase(int pm) { return (pm >> 3) * LP + 128 + (pm & 7) * 256; }
namespace pg8 {
constexpr int BM = 256, BK = 64, HALF = 128, HTB = HALF * BK * 2, STAGE_BYTES = 8 * HTB, NXCD = 8, WGM = 8;
DI int lds_byte(int r, int c) { const int st = (r >> 4) * 2 + (c >> 5), rr = r & 15, cc = c & 31, ob = rr * 64 + cc * 2; return st * 1024 + (ob ^ (((ob >> 9) & 1) << 5)); }
DI void stage_rc(int b, int& R, int& C) { const int st = b / 1024, sb = b % 1024, swz = sb ^ (((sb >> 9) & 1) << 5); R = (st >> 1) * 16 + swz / 64; C = (st & 1) * 32 + (swz % 64) / 2; }
DI int perm32(int rho) { const int n = rho >> 4, i = rho & 15; return 8 * (i >> 2) + 4 * n + (i & 3); }
struct Unit { int pm, pn; };
struct Gemm { const bf16_t* A; const bf16_t* Bt; int M, N, K; };
struct StaticOrder {
    int nM, nN, nwg, G, c;
    DI void init(int M, int N, int G_, int c_) { nM = M / BM; nN = N / BM; nwg = nM * nN; G = G_; c = c_; }
    DI bool next(int i, Unit& u) const {
        const long L = (long)i * G + c; if (L >= nwg) return false;
        int wgid = (int)L; { const int q = nwg / NXCD, r = nwg % NXCD, xcd = wgid % NXCD, off = wgid / NXCD; wgid = (xcd < r ? xcd * (q + 1) : r * (q + 1) + (xcd - r) * q) + off; }
        const int nig = WGM * nN, gid = wgid / nig, fm = gid * WGM, gsz = (nM - fm) < WGM ? (nM - fm) : WGM;
        u.pm = fm + ((wgid % nig) % gsz); u.pn = (wgid % nig) / gsz; return true;
    }
    DI void a_ready(const Unit&) const {}
    DI void done(const Unit&) const {}
};

template <class Epi, class Sched>
DI void gemm_phase(LAS unsigned char* lds, const Gemm g, const Sched& S, const Epi& E) {
    const int tid = opaque_tid(), wid = __builtin_amdgcn_readfirstlane(tid >> 6), lane = tid & 63, wr = wid >> 2, wc = wid & 3, fr = lane & 15, fq = lane >> 4;
    const int K = g.K, nt = K / BK;
    unsigned voffA[2], voffB[2];
#pragma unroll
    for (int i = 0; i < 2; ++i) { int R, C; stage_rc(tid * 16 + i * 8192, R, C); const int Rb = Epi::PERM ? ((R & ~31) + perm32(R & 31)) : R;
        voffA[i] = (unsigned)(R * K + C) * 2u; voffB[i] = (unsigned)(Rb * K + C) * 2u; }
    const size_t kstep = (size_t)(BK * 2);
    const size_t hstep = (size_t)HALF * K * 2;
    const size_t tstep = 2 * hstep;
    const unsigned ldsw = (unsigned)wid * 1024u;
    const int aoff = lds_byte(wr * 64 + fr, fq * 8), boff = lds_byte(wc * 32 + fr, fq * 8);
#define PG8_SA(b, h) (((b) * 2 + (h)) * HTB)
#define PG8_SB(b, h) ((4 + (b) * 2 + (h)) * HTB)
#define PG8_STAGE(bufoff, gbase, voff) do { _Pragma("unroll") for (int _i = 0; _i < 2; ++_i) \
        __builtin_amdgcn_global_load_lds((const unsigned*)((const char*)(gbase) + (voff)[_i]), (LAS unsigned*)(lds + (bufoff) + ldsw + _i * 8192), 16, 0, 0); } while (0)
#define PG8_LDA(dst, b, h) do { _Pragma("unroll") for (int m = 0; m < 4; ++m) _Pragma("unroll") for (int k = 0; k < 2; ++k) dst[m][k] = *(const LAS bf16x8*)(lds + PG8_SA(b, h) + aoff + m * 2048 + k * 1024); } while (0)
#define PG8_LDB(dst, b, h) do { _Pragma("unroll") for (int n = 0; n < 2; ++n) _Pragma("unroll") for (int k = 0; k < 2; ++k) dst[n][k] = *(const LAS bf16x8*)(lds + PG8_SB(b, h) + boff + n * 2048 + k * 1024); } while (0)
#define PG8_MMA(ai, bj, At, Bt) do { __builtin_amdgcn_s_setprio(1); _Pragma("unroll") for (int m = 0; m < 4; ++m) _Pragma("unroll") for (int n = 0; n < 2; ++n) _Pragma("unroll") for (int k = 0; k < 2; ++k) \
        acc[ai][bj][m][n] = __builtin_amdgcn_mfma_f32_16x16x32_bf16(Bt[n][k], At[m][k], acc[ai][bj][m][n], 0, 0, 0); __builtin_amdgcn_s_setprio(0); } while (0)
#define PG8_WAIT_V(n) asm volatile("s_waitcnt vmcnt(" #n ")" ::: "memory")
#define PG8_WAIT_L(n) asm volatile("s_waitcnt lgkmcnt(" #n ")" ::: "memory")
#define PG8_BAR __builtin_amdgcn_s_barrier()
#define PG8_SCHED __builtin_amdgcn_sched_barrier(0)
    Unit cur, nxt; int ui = 0;
    if (!S.next(0, cur)) return;
    f32x4 acc[2][2][4][2];
#pragma unroll
    for (int a = 0; a < 2; ++a)
#pragma unroll
        for (int b = 0; b < 2; ++b)
#pragma unroll
            for (int m = 0; m < 4; ++m)
#pragma unroll
                for (int n = 0; n < 2; ++n) acc[a][b][m][n] = (f32x4){0.f, 0.f, 0.f, 0.f};
    bf16x8 At[4][2], B0[2][2], B1[2][2];
    const char* cA = (const char*)g.A + (size_t)rowbase(cur.pm) * K * 2; const char* cB = (const char*)g.Bt + (size_t)cur.pn * tstep;
    S.a_ready(cur);
    PG8_STAGE(PG8_SB(0, 0), cB, voffB); PG8_STAGE(PG8_SA(0, 0), cA, voffA); PG8_STAGE(PG8_SB(0, 1), cB + hstep, voffB); PG8_STAGE(PG8_SA(0, 1), cA + hstep, voffA);
    if (wr == 1) PG8_BAR;
    PG8_WAIT_V(4); PG8_BAR;
    PG8_STAGE(PG8_SB(1, 0), cB + kstep, voffB); PG8_STAGE(PG8_SA(1, 0), cA + kstep, voffA); PG8_STAGE(PG8_SB(1, 1), cB + hstep + kstep, voffB);
    PG8_WAIT_V(6); PG8_BAR;
    for (;;) {
        const bool has_next = S.next(ui + 1, nxt);
        const char* nA = has_next ? (const char*)g.A + (size_t)rowbase(nxt.pm) * K * 2 : cA; const char* nB = has_next ? (const char*)g.Bt + (size_t)nxt.pn * tstep : cB;
        constexpr int NH = Epi::MID_HOOK ? 2 : 1;
#pragma nounroll
        for (int hh = 0; hh < NH; ++hh) {
        if constexpr (Epi::MID_HOOK) { if (hh == 1) { const int l2 = opaque_tid() & 63; E.mid(acc, cur, wr, wc, l2 & 15, l2 >> 4); } }
        for (int t = hh * (nt / NH); t < (hh + 1) * (nt / NH); t += 2) {
            const bool last = (t == nt - 2);
            const char* a1 = cA + (size_t)(t + 1) * kstep;
            const char* a2 = last ? nA : cA + (size_t)(t + 2) * kstep; const char* b2 = last ? nB : cB + (size_t)(t + 2) * kstep;
            const char* a3 = a2 + kstep; const char* b3 = b2 + kstep;
            if (last && has_next) S.a_ready(nxt);
            PG8_LDB(B0, 0, 0); PG8_SCHED; PG8_LDA(At, 0, 0); PG8_STAGE(PG8_SA(1, 1), a1 + hstep, voffA);
            PG8_WAIT_L(8); PG8_BAR; PG8_WAIT_L(0); PG8_MMA(0, 0, At, B0); PG8_BAR; PG8_SCHED;
            PG8_LDB(B1, 0, 1); PG8_STAGE(PG8_SB(0, 0), b2, voffB);
            PG8_BAR; PG8_WAIT_L(0); PG8_MMA(0, 1, At, B1); PG8_BAR;
            PG8_LDA(At, 0, 1); PG8_STAGE(PG8_SA(0, 0), a2, voffA);
            PG8_BAR; PG8_WAIT_L(0); PG8_MMA(1, 0, At, B0); PG8_BAR; PG8_SCHED;
            PG8_STAGE(PG8_SB(0, 1), b2 + hstep, voffB);
            PG8_WAIT_V(6); PG8_BAR; PG8_MMA(1, 1, At, B1); PG8_BAR;
            PG8_LDB(B0, 1, 0); PG8_SCHED; PG8_LDA(At, 1, 0); PG8_STAGE(PG8_SA(0, 1), a2 + hstep, voffA);
            PG8_WAIT_L(8); PG8_BAR; PG8_WAIT_L(0); PG8_MMA(0, 0, At, B0); PG8_BAR; PG8_SCHED;
            PG8_LDB(B1, 1, 1); PG8_STAGE(PG8_SB(1, 0), b3, voffB);
            PG8_BAR; PG8_WAIT_L(0); PG8_MMA(0, 1, At, B1); PG8_BAR;
            PG8_LDA(At, 1, 1); PG8_STAGE(PG8_SA(1, 0), a3, voffA);
            PG8_BAR; PG8_WAIT_L(0); PG8_MMA(1, 0, At, B0); PG8_BAR; PG8_SCHED;
            PG8_STAGE(PG8_SB(1, 1), b3 + hstep, voffB);
            PG8_WAIT_V(6); PG8_BAR; PG8_MMA(1, 1, At, B1); PG8_BAR;
        }
        }
        if constexpr (!Epi::AFTER_DRAIN) { const int l2 = opaque_tid() & 63; E(acc, cur, wr, wc, l2 & 15, l2 >> 4); } S.done(cur);
        if (!has_next) break;
#pragma unroll
        for (int a = 0; a < 2; ++a)
#pragma unroll
            for (int b = 0; b < 2; ++b)
#pragma unroll
                for (int m = 0; m < 4; ++m)
#pragma unroll
                    for (int n = 0; n < 2; ++n) acc[a][b][m][n] = (f32x4){0.f, 0.f, 0.f, 0.f};
        cur = nxt; cA = nA; cB = nB; ++ui;
    }
    PG8_WAIT_V(0);
    if (wr == 0) PG8_BAR;
    PG8_BAR;
    if constexpr (Epi::AFTER_DRAIN) { const int l2 = opaque_tid() & 63; E.fused(acc, cur, wr, wc, l2 & 15, l2 >> 4); }
#undef PG8_SA
#undef PG8_SB
#undef PG8_STAGE
#undef PG8_LDA
#undef PG8_LDB
#undef PG8_MMA
#undef PG8_WAIT_V
#undef PG8_WAIT_L
#undef PG8_BAR
#undef PG8_SCHED
}
}
using pg8::Unit;

struct EpiIn {
    static constexpr bool PERM = true, AFTER_DRAIN = false, MID_HOOK = false;
    bf16_t* P; const float* TA; const float* TR;
    template <int KIND> DI void g8k(int row, int col, f32x4 v0, f32x4 v1) const {
        const int l = row % LP;
        if (KIND == 0 || KIND == 2) {
            const float* t = (KIND == 0) ? TA + ((size_t)l * 32 + ((col & 63) >> 1)) * 2 : TR + ((size_t)l * 64 + ((col & 127) >> 1)) * 2;
            const f32x4 t0 = *(const f32x4*)t, t1 = *(const f32x4*)(t + 4);
            f32x4 w0, w1;
            w0[0] = v0[0] * t0[0] - v0[1] * t0[1]; w0[1] = v0[1] * t0[0] + v0[0] * t0[1];
            w0[2] = v0[2] * t0[2] - v0[3] * t0[3]; w0[3] = v0[3] * t0[2] + v0[2] * t0[3];
            w1[0] = v1[0] * t1[0] - v1[1] * t1[1]; w1[1] = v1[1] * t1[0] + v1[0] * t1[1];
            w1[2] = v1[2] * t1[2] - v1[3] * t1[3]; w1[3] = v1[3] * t1[2] + v1[2] * t1[3];
            v0 = w0; v1 = w1;
            if (KIND == 2 && col >= C_RK) { const float sc = (l >= PADR) ? 0.08838834764831845f : 0.0f; v0 *= sc; v1 *= sc; }
        }
        if (KIND == 3) {
#pragma unroll
            for (int j = 0; j < 4; ++j) { v0[j] = v0[j] * sigmoidf_(v0[j]); v1[j] = v1[j] * sigmoidf_(v1[j]); }
        }
        if (KIND == 4) {
#pragma unroll
            for (int j = 0; j < 4; ++j) { v0[j] = sigmoidf_(v0[j]); v1[j] = sigmoidf_(v1[j]); }
        }
        u32x4 w; w.x = pk2(v0[0], v0[1]); w.y = pk2(v0[2], v0[3]); w.z = pk2(v1[0], v1[1]); w.w = pk2(v1[2], v1[3]);
        *(u32x4*)(P + (size_t)row * PLD + col) = w;
    }
    DI void g8(int row, int col, f32x4 v0, f32x4 v1) const {
        const int pn = col >> 8;
        if (pn < 16) g8k<0>(row, col, v0, v1);
        else if (pn < 24) g8k<1>(row, col, v0, v1);
        else if (pn < 32) g8k<2>(row, col, v0, v1);
        else if (pn < 40) g8k<1>(row, col, v0, v1);
        else if (pn < 48) g8k<3>(row, col, v0, v1);
        else g8k<4>(row, col, v0, v1);
    }
    template <int KIND> DI void g8rot(int row, int col, f32x4 v0, f32x4 v1, const f32x4 t0, const f32x4 t1) const {
        f32x4 w0, w1;
        w0[0] = v0[0] * t0[0] - v0[1] * t0[1]; w0[1] = v0[1] * t0[0] + v0[0] * t0[1];
        w0[2] = v0[2] * t0[2] - v0[3] * t0[3]; w0[3] = v0[3] * t0[2] + v0[2] * t0[3];
        w1[0] = v1[0] * t1[0] - v1[1] * t1[1]; w1[1] = v1[1] * t1[0] + v1[0] * t1[1];
        w1[2] = v1[2] * t1[2] - v1[3] * t1[3]; w1[3] = v1[3] * t1[2] + v1[2] * t1[3];
        if (KIND == 2 && col >= C_RK) { const float sc = ((row % LP) >= PADR) ? 0.08838834764831845f : 0.0f; w0 *= sc; w1 *= sc; }
        u32x4 w; w.x = pk2(w0[0], w0[1]); w.y = pk2(w0[2], w0[3]); w.z = pk2(w1[0], w1[1]); w.w = pk2(w1[2], w1[3]);
        *(u32x4*)(P + (size_t)row * PLD + col) = w;
    }
    template <int KIND> DI void run(const f32x4 (&acc)[2][2][4][2], const Unit& u, int wr, int wc, int fr, int fq) const {
        int row0 = rowbase(u.pm) + wr * 64 + fr, col0 = u.pn * 256 + wc * 32 + 8 * fq;
        asm volatile("" : "+v"(row0), "+v"(col0));
        if constexpr (KIND == 0 || KIND == 2) {
#pragma unroll
            for (int ai = 0; ai < 2; ++ai) {
                f32x4 ta[4], tb[4];
#pragma unroll
                for (int m = 0; m < 4; ++m) {
                    const int l = (row0 + ai * 128 + m * 16) % LP;
                    const float* t = (KIND == 0) ? TA + ((size_t)l * 32 + ((col0 & 63) >> 1)) * 2 : TR + ((size_t)l * 64 + ((col0 & 127) >> 1)) * 2;
                    ta[m] = *(const f32x4*)t; tb[m] = *(const f32x4*)(t + 4);
                }
                __builtin_amdgcn_sched_barrier(0);
#pragma unroll
                for (int m = 0; m < 4; ++m)
#pragma unroll
                    for (int bj = 0; bj < 2; ++bj) { g8rot<KIND>(row0 + ai * 128 + m * 16, col0 + bj * 128, acc[ai][bj][m][0], acc[ai][bj][m][1], ta[m], tb[m]); __builtin_amdgcn_sched_barrier(0); }
            }
        } else {
#pragma unroll
            for (int ai = 0; ai < 2; ++ai)
#pragma unroll
                for (int m = 0; m < 4; ++m)
#pragma unroll
                    for (int bj = 0; bj < 2; ++bj) { g8k<KIND>(row0 + ai * 128 + m * 16, col0 + bj * 128, acc[ai][bj][m][0], acc[ai][bj][m][1]); __builtin_amdgcn_sched_barrier(0); }
        }
    }
    DI void operator()(const f32x4 (&acc)[2][2][4][2], const Unit& u, int wr, int wc, int fr, int fq) const {
        const int pn = u.pn;
        if (pn < 16) run<0>(acc, u, wr, wc, fr, fq);
        else if (pn < 24) run<1>(acc, u, wr, wc, fr, fq);
        else if (pn < 32) run<2>(acc, u, wr, wc, fr, fq);
        else if (pn < 40) run<1>(acc, u, wr, wc, fr, fq);
        else if (pn < 48) run<3>(acc, u, wr, wc, fr, fq);
        else run<4>(acc, u, wr, wc, fr, fq);
    }
};
template <int WHICH> struct EpiBr {
    static constexpr bool PERM = true, AFTER_DRAIN = false, MID_HOOK = false;
    const bf16_t* P; float* TMP; bf16_t* MG;
    DI void g8(int row, int col, f32x4 a0, f32x4 a1) const {
        const u32x4 gw = *(const u32x4*)(P + (size_t)row * PLD + (WHICH == 0 ? C_GA : C_GB) + col);
        f32x4 g0, g1;
        g0[0] = bf2f(gw.x & 0xffffu); g0[1] = bf2f(gw.x >> 16); g0[2] = bf2f(gw.y & 0xffffu); g0[3] = bf2f(gw.y >> 16);
        g1[0] = bf2f(gw.z & 0xffffu); g1[1] = bf2f(gw.z >> 16); g1[2] = bf2f(gw.w & 0xffffu); g1[3] = bf2f(gw.w >> 16);
        f32x4 v0 = a0 * g0, v1 = a1 * g1;
        float* tp = TMP + (size_t)row * D + col;
        if (WHICH == 0) { *(f32x4*)tp = v0; *(f32x4*)(tp + 4) = v1; }
        else {
            v0 += *(const f32x4*)tp; v1 += *(const f32x4*)(tp + 4);
            u32x4 w; w.x = pk2(v0[0], v0[1]); w.y = pk2(v0[2], v0[3]); w.z = pk2(v1[0], v1[1]); w.w = pk2(v1[2], v1[3]);
            *(u32x4*)(MG + (size_t)row * D + col) = w;
        }
    }
    DI void operator()(const f32x4 (&acc)[2][2][4][2], const Unit& u, int wr, int wc, int fr, int fq) const {
        const int row0 = rowbase(u.pm) + wr * 64 + fr, col0 = u.pn * 256 + wc * 32 + 8 * fq;
#pragma unroll
        for (int ai = 0; ai < 2; ++ai)
#pragma unroll
            for (int m = 0; m < 4; ++m)
#pragma unroll
                for (int bj = 0; bj < 2; ++bj) g8(row0 + ai * 128 + m * 16, col0 + bj * 128, acc[ai][bj][m][0], acc[ai][bj][m][1]);
    }
};
struct EpiRes {
    static constexpr bool PERM = false, AFTER_DRAIN = false, MID_HOOK = false;
    const float* HF; float* PRE;
    DI void g4(int row, int col, f32x4 a) const {
        const size_t o = (size_t)row * D + col;
        *(f32x4*)(PRE + o) = *(const f32x4*)(HF + o) * ALPHA + a;
    }
    DI void g8(int row, int col, f32x4 a0, f32x4 a1) const { g4(row, col, a0); g4(row, col + 4, a1); }
    DI void operator()(const f32x4 (&acc)[2][2][4][2], const Unit& u, int wr, int wc, int fr, int fq) const {
        const int row0 = rowbase(u.pm) + wr * 64 + fr, col0 = u.pn * 256 + wc * 32 + 4 * fq;
#pragma unroll
        for (int ai = 0; ai < 2; ++ai)
#pragma unroll
            for (int m = 0; m < 4; ++m)
#pragma unroll
                for (int bj = 0; bj < 2; ++bj)
#pragma unroll
                    for (int n = 0; n < 2; ++n) g4(row0 + ai * 128 + m * 16, col0 + bj * 128 + n * 16, acc[ai][bj][m][n]);
    }
};
struct EpiUp {
    static constexpr bool PERM = true, AFTER_DRAIN = false, MID_HOOK = false;
    bf16_t* U;
    DI void g8(int row, int col, f32x4 v0, f32x4 v1) const {
        u32x4 w; w.x = pk2(v0[0], v0[1]); w.y = pk2(v0[2], v0[3]); w.z = pk2(v1[0], v1[1]); w.w = pk2(v1[2], v1[3]);
        *(u32x4*)(U + (size_t)row * DFF2 + col) = w;
    }
    DI void operator()(const f32x4 (&acc)[2][2][4][2], const Unit& u, int wr, int wc, int fr, int fq) const {
        int row0 = rowbase(u.pm) + wr * 64 + fr, col0 = u.pn * 256 + wc * 32 + 8 * fq;
        asm volatile("" : "+v"(row0), "+v"(col0));
#pragma unroll
        for (int ai = 0; ai < 2; ++ai)
#pragma unroll
            for (int m = 0; m < 4; ++m)
#pragma unroll
                for (int bj = 0; bj < 2; ++bj) g8(row0 + ai * 128 + m * 16, col0 + bj * 128, acc[ai][bj][m][0], acc[ai][bj][m][1]);
    }
};

template <class Epi> DI void meta_gemm(const bf16_t* __restrict__ A, const bf16_t* __restrict__ Bt, int N, int K, const Epi& E, unsigned char* smem) {
    const int tid = opaque_tid(), wid = __builtin_amdgcn_readfirstlane(tid >> 6), lane = tid & 63, i16 = lane & 15, kq = lane >> 4;
    float* R = (float*)smem;
    const int nsteps = K / 32, s0 = (wid * nsteps) >> 3, s1 = ((wid + 1) * nsteps) >> 3;
    const bf16_t* ap = A + (size_t)(PADR + i16) * K + 8 * kq;
    for (int task = blockIdx.x; task < N / 32; task += gridDim.x) {
        const int cbase = task * 32;
        const bf16_t* w0 = Bt + (size_t)(cbase + 8 * (i16 >> 2) + (i16 & 3)) * K + 8 * kq;
        const bf16_t* w1 = w0 + (size_t)4 * K;
        f32x4 c0 = {0.f, 0.f, 0.f, 0.f}, c1 = {0.f, 0.f, 0.f, 0.f};
#pragma unroll 4
        for (int st = s0; st < s1; ++st) {
            const bf16x8 af = *(const bf16x8*)(ap + st * 32);
            const bf16x8 b0 = *(const bf16x8*)(w0 + st * 32), b1 = *(const bf16x8*)(w1 + st * 32);
            c0 = __builtin_amdgcn_mfma_f32_16x16x32_bf16(b0, af, c0, 0, 0, 0);
            c1 = __builtin_amdgcn_mfma_f32_16x16x32_bf16(b1, af, c1, 0, 0, 0);
        }
        *(f32x4*)(R + ((wid * 2 + 0) * 64 + lane) * 4) = c0;
        *(f32x4*)(R + ((wid * 2 + 1) * 64 + lane) * 4) = c1;
        __syncthreads();
        if (wid == 0) {
            f32x4 v0 = {0.f, 0.f, 0.f, 0.f}, v1 = {0.f, 0.f, 0.f, 0.f};
#pragma unroll
            for (int w = 0; w < 8; ++w) { v0 += *(const f32x4*)(R + ((w * 2 + 0) * 64 + lane) * 4); v1 += *(const f32x4*)(R + ((w * 2 + 1) * 64 + lane) * 4); }
            for (int b = 0; b < NB; ++b) E.g8(b * LP + PADR + i16, cbase + 8 * kq, v0, v1);
        }
        __syncthreads();
    }
}


struct EpiMerge {
    static constexpr bool PERM = true, AFTER_DRAIN = false, MID_HOOK = true;
    const bf16_t* P; bf16_t* MG;
    DI static void unpack8(const u32x4 gw, f32x4& g0, f32x4& g1) {
        g0[0] = bf2f(gw.x & 0xffffu); g0[1] = bf2f(gw.x >> 16); g0[2] = bf2f(gw.y & 0xffffu); g0[3] = bf2f(gw.y >> 16);
        g1[0] = bf2f(gw.z & 0xffffu); g1[1] = bf2f(gw.z >> 16); g1[2] = bf2f(gw.w & 0xffffu); g1[3] = bf2f(gw.w >> 16);
    }
    DI void mid(f32x4 (&acc)[2][2][4][2], const Unit& u, int wr, int wc, int fr, int fq) const {
        int row0 = rowbase(u.pm) + wr * 64 + fr, col0 = u.pn * 256 + wc * 32 + 8 * fq;
        asm volatile("" : "+v"(row0), "+v"(col0));
#pragma unroll
        for (int ai = 0; ai < 2; ++ai)
#pragma unroll
            for (int m = 0; m < 4; ++m)
#pragma unroll
                for (int bj = 0; bj < 2; ++bj) {
                    const bf16_t* gp = P + (size_t)(row0 + ai * 128 + m * 16) * PLD + col0 + bj * 128;
                    f32x4 a0, a1, b0, b1;
                    unpack8(*(const u32x4*)(gp + C_GA), a0, a1); unpack8(*(const u32x4*)(gp + C_GB), b0, b1);
#pragma unroll
                    for (int j = 0; j < 4; ++j) { acc[ai][bj][m][0][j] *= a0[j] * __builtin_amdgcn_rcpf(b0[j]); acc[ai][bj][m][1][j] *= a1[j] * __builtin_amdgcn_rcpf(b1[j]); }
                    asm volatile("" ::: "memory");
                }
    }
    DI void operator()(const f32x4 (&acc)[2][2][4][2], const Unit& u, int wr, int wc, int fr, int fq) const {
        int row0 = rowbase(u.pm) + wr * 64 + fr, col0 = u.pn * 256 + wc * 32 + 8 * fq;
        asm volatile("" : "+v"(row0), "+v"(col0));
#pragma unroll
        for (int ai = 0; ai < 2; ++ai)
#pragma unroll
            for (int m = 0; m < 4; ++m)
#pragma unroll
                for (int bj = 0; bj < 2; ++bj) {
                    const int row = row0 + ai * 128 + m * 16, col = col0 + bj * 128;
                    f32x4 b0, b1;
                    unpack8(*(const u32x4*)(P + (size_t)row * PLD + C_GB + col), b0, b1);
                    const f32x4 v0 = acc[ai][bj][m][0] * b0, v1 = acc[ai][bj][m][1] * b1;
                    u32x4 w; w.x = pk2(v0[0], v0[1]); w.y = pk2(v0[2], v0[3]); w.z = pk2(v1[0], v1[1]); w.w = pk2(v1[2], v1[3]);
                    *(u32x4*)(MG + (size_t)row * D + col) = w;
                }
    }
};
DI void meta_gemm_merge(const bf16_t* __restrict__ A, const bf16_t* __restrict__ Bt, const EpiMerge& E, unsigned char* smem) {
    const int tid = opaque_tid(), wid = __builtin_amdgcn_readfirstlane(tid >> 6), lane = tid & 63, i16 = lane & 15, kq = lane >> 4;
    float* R = (float*)smem;
    constexpr int K2 = 2 * D, nsteps = K2 / 32;
    const int s0 = (wid * nsteps) >> 3, s1 = ((wid + 1) * nsteps) >> 3;
    const bf16_t* ap = A + (size_t)(PADR + i16) * K2 + 8 * kq;
    const int task = blockIdx.x;
    if (task >= D / 32) return;
    const int cbase = task * 32;
    const bf16_t* w0 = Bt + (size_t)(cbase + 8 * (i16 >> 2) + (i16 & 3)) * K2 + 8 * kq;
    const bf16_t* w1 = w0 + (size_t)4 * K2;
    f32x4 c0 = {0.f, 0.f, 0.f, 0.f}, c1 = {0.f, 0.f, 0.f, 0.f};
#pragma unroll 4
    for (int st = s0; st < s1; ++st) {
        const bf16x8 af = *(const bf16x8*)(ap + st * 32);
        const bf16x8 b0 = *(const bf16x8*)(w0 + st * 32), b1 = *(const bf16x8*)(w1 + st * 32);
        c0 = __builtin_amdgcn_mfma_f32_16x16x32_bf16(b0, af, c0, 0, 0, 0);
        c1 = __builtin_amdgcn_mfma_f32_16x16x32_bf16(b1, af, c1, 0, 0, 0);
    }
    *(f32x4*)(R + ((wid * 2 + 0) * 64 + lane) * 4) = c0;
    *(f32x4*)(R + ((wid * 2 + 1) * 64 + lane) * 4) = c1;
    __syncthreads();
    if (wid == 0) {
        f32x4 a0 = {0.f, 0.f, 0.f, 0.f}, a1 = a0, b0 = a0, b1 = a0;
#pragma unroll
        for (int w = 0; w < 4; ++w) { a0 += *(const f32x4*)(R + ((w * 2 + 0) * 64 + lane) * 4); a1 += *(const f32x4*)(R + ((w * 2 + 1) * 64 + lane) * 4); }
#pragma unroll
        for (int w = 4; w < 8; ++w) { b0 += *(const f32x4*)(R + ((w * 2 + 0) * 64 + lane) * 4); b1 += *(const f32x4*)(R + ((w * 2 + 1) * 64 + lane) * 4); }
        const int col = cbase + 8 * kq;
        const bf16_t* gp = E.P + (size_t)(PADR + i16) * PLD + col;
        f32x4 ga0, ga1, gb0, gb1;
        EpiMerge::unpack8(*(const u32x4*)(gp + C_GA), ga0, ga1); EpiMerge::unpack8(*(const u32x4*)(gp + C_GB), gb0, gb1);
        const f32x4 v0 = a0 * ga0 + b0 * gb0, v1 = a1 * ga1 + b1 * gb1;
        u32x4 w; w.x = pk2(v0[0], v0[1]); w.y = pk2(v0[2], v0[3]); w.z = pk2(v1[0], v1[1]); w.w = pk2(v1[2], v1[3]);
        for (int bb = 0; bb < NB; ++bb) *(u32x4*)(E.MG + (size_t)(bb * LP + PADR + i16) * D + col) = w;
    }
    __syncthreads();
}

struct EpiLN {
    static constexpr bool PERM = false, AFTER_DRAIN = true, MID_HOOK = false;
    float* HF; bf16_t* HB; float* OUT; const float* g; const float* b; float* STATS; unsigned* cnt; unsigned char* smem;
    DI void fused(f32x4 (&acc)[2][2][4][2], const Unit& u, int wr, int wc, int fr, int fq) const {
        const int tid = opaque_tid();
        const int rb = rowbase(u.pm), rl0 = wr * 64 + fr, col0 = u.pn * 256 + wc * 32 + 4 * fq;
        float* part = (float*)smem;
        float* mr = part + 2048;
#pragma unroll
        for (int ai = 0; ai < 2; ++ai)
#pragma unroll
            for (int m = 0; m < 4; ++m) {
                const int rl = rl0 + ai * 128 + m * 16;
                const size_t ro = (size_t)(rb + rl) * D + col0;
                float sm = 0.f, sq = 0.f;
#pragma unroll
                for (int bj = 0; bj < 2; ++bj)
#pragma unroll
                    for (int n = 0; n < 2; ++n) {
                        const f32x4 x = *(const f32x4*)(HF + ro + bj * 128 + n * 16) * ALPHA + acc[ai][bj][m][n];
                        acc[ai][bj][m][n] = x;
                        sm += (x[0] + x[1]) + (x[2] + x[3]); sq += (x[0] * x[0] + x[1] * x[1]) + (x[2] * x[2] + x[3] * x[3]);
                    }
                sm += shx(sm, 16); sq += shx(sq, 16);
                sm += shx(sm, 32); sq += shx(sq, 32);
                if (fq == 0) { part[(wc * 256 + rl) * 2] = sm; part[(wc * 256 + rl) * 2 + 1] = sq; }
            }
        __syncthreads();
        if (tid < 256) {
            float S = 0.f, Q = 0.f;
#pragma unroll
            for (int w = 0; w < 4; ++w) { S += part[(w * 256 + tid) * 2]; Q += part[(w * 256 + tid) * 2 + 1]; }
            f32x2 v = {S, Q};
            st8_wt(STATS + ((size_t)(u.pm * 8 + u.pn) * 256 + tid) * 2, v);
        }
        asm volatile("s_waitcnt vmcnt(0)" ::: "memory");
        __syncthreads();
        if (tid == 0) {
            ab_add(cnt + u.pm, 1u);
            AB_SPIN(ab_ld(cnt + u.pm) < 8u);
            __builtin_amdgcn_fence(__ATOMIC_ACQUIRE, "agent"); asm volatile("s_waitcnt vmcnt(0)" ::: "memory");
        }
        __syncthreads();
        if (tid < 256) {
            float S = 0.f, Q = 0.f;
#pragma unroll
            for (int p = 0; p < 8; ++p) { const f32x2 v = *(const f32x2*)(STATS + ((size_t)(u.pm * 8 + p) * 256 + tid) * 2); S += v[0]; Q += v[1]; }
            const float mean = S * (1.0f / D), var = fmaxf(Q * (1.0f / D) - mean * mean, 0.f);
            mr[tid * 2] = mean; mr[tid * 2 + 1] = rsqrtf(var + EPS);
        }
        __syncthreads();
        f32x4 gv[2][2], bv[2][2];
#pragma unroll
        for (int bj = 0; bj < 2; ++bj)
#pragma unroll
            for (int n = 0; n < 2; ++n) { gv[bj][n] = *(const f32x4*)(g + col0 + bj * 128 + n * 16); bv[bj][n] = *(const f32x4*)(b + col0 + bj * 128 + n * 16); }
#pragma unroll
        for (int ai = 0; ai < 2; ++ai)
#pragma unroll
            for (int m = 0; m < 4; ++m) {
                const int rl = rl0 + ai * 128 + m * 16, row = rb + rl;
                const float mean = mr[rl * 2], rstd = mr[rl * 2 + 1];
#pragma unroll
                for (int bj = 0; bj < 2; ++bj)
#pragma unroll
                    for (int n = 0; n < 2; ++n) {
                        const int col = col0 + bj * 128 + n * 16;
                        const f32x4 y = (acc[ai][bj][m][n] - mean) * rstd * gv[bj][n] + bv[bj][n];
                        if (OUT) { const int bb = row / LP, l = row % LP; *(f32x4*)(OUT + ((size_t)bb * SEQ + (l - 128)) * D + col) = y; }
                        else {
                            *(f32x4*)(HF + (size_t)row * D + col) = y;
                            u32x2 w; w.x = pk2(y[0], y[1]); w.y = pk2(y[2], y[3]);
                            *(u32x2*)(HB + (size_t)row * D + col) = w;
                        }
                    }
            }
        __syncthreads();
    }
};
DI void meta_gemm_ln(const bf16_t* __restrict__ A, const bf16_t* __restrict__ Bt, int K, const EpiLN& E, unsigned char* smem) {
    const int tid = opaque_tid(), wid = __builtin_amdgcn_readfirstlane(tid >> 6), lane = tid & 63, i16 = lane & 15, kq = lane >> 4;
    float* R = (float*)smem;
    const int nsteps = K / 32, s0 = (wid * nsteps) >> 3, s1 = ((wid + 1) * nsteps) >> 3;
    const bf16_t* ap = A + (size_t)(PADR + i16) * K + 8 * kq;
    const int task = blockIdx.x;
    if (task >= D / 32) return;
    const int cbase = task * 32;
    const bf16_t* w0 = Bt + (size_t)(cbase + 8 * (i16 >> 2) + (i16 & 3)) * K + 8 * kq;
    const bf16_t* w1 = w0 + (size_t)4 * K;
    f32x4 c0 = {0.f, 0.f, 0.f, 0.f}, c1 = {0.f, 0.f, 0.f, 0.f};
#pragma unroll 4
    for (int st = s0; st < s1; ++st) {
        const bf16x8 af = *(const bf16x8*)(ap + st * 32);
        const bf16x8 b0 = *(const bf16x8*)(w0 + st * 32), b1 = *(const bf16x8*)(w1 + st * 32);
        c0 = __builtin_amdgcn_mfma_f32_16x16x32_bf16(b0, af, c0, 0, 0, 0);
        c1 = __builtin_amdgcn_mfma_f32_16x16x32_bf16(b1, af, c1, 0, 0, 0);
    }
    *(f32x4*)(R + ((wid * 2 + 0) * 64 + lane) * 4) = c0;
    *(f32x4*)(R + ((wid * 2 + 1) * 64 + lane) * 4) = c1;
    __syncthreads();
    if (wid == 0) {
        f32x4 v0 = {0.f, 0.f, 0.f, 0.f}, v1 = {0.f, 0.f, 0.f, 0.f};
#pragma unroll
        for (int w = 0; w < 8; ++w) { v0 += *(const f32x4*)(R + ((w * 2 + 0) * 64 + lane) * 4); v1 += *(const f32x4*)(R + ((w * 2 + 1) * 64 + lane) * 4); }
        const int col = cbase + 8 * kq;
        const size_t o0 = (size_t)(PADR + i16) * D + col;
        v0 += *(const f32x4*)(E.HF + o0) * ALPHA; v1 += *(const f32x4*)(E.HF + o0 + 4) * ALPHA;
        float sm = (v0[0] + v0[1]) + (v0[2] + v0[3]) + (v1[0] + v1[1]) + (v1[2] + v1[3]);
        float sq = (v0[0] * v0[0] + v0[1] * v0[1]) + (v0[2] * v0[2] + v0[3] * v0[3]) + (v1[0] * v1[0] + v1[1] * v1[1]) + (v1[2] * v1[2] + v1[3] * v1[3]);
        sm += shx(sm, 16); sq += shx(sq, 16);
        sm += shx(sm, 32); sq += shx(sq, 32);
        float* SM = E.STATS + (size_t)32 * 8 * 256 * 2;
        if (kq == 0) { f32x2 v = {sm, sq}; st8_wt(SM + (task * 16 + i16) * 2, v); }
        asm volatile("s_waitcnt vmcnt(0)" ::: "memory");
        if (lane == 0) {
            ab_add(E.cnt + 32, 1u);
            AB_SPIN(ab_ld(E.cnt + 32) < 64u);
            __builtin_amdgcn_fence(__ATOMIC_ACQUIRE, "agent"); asm volatile("s_waitcnt vmcnt(0)" ::: "memory");
        }
        __builtin_amdgcn_wave_barrier();
        float S = 0.f, Q = 0.f;
        for (int t = 0; t < 64; ++t) { const f32x2 v = *(const f32x2*)(SM + (t * 16 + i16) * 2); S += v[0]; Q += v[1]; }
        const float mean = S * (1.0f / D), var = fmaxf(Q * (1.0f / D) - mean * mean, 0.f), rstd = rsqrtf(var + EPS);
        const f32x4 g0 = *(const f32x4*)(E.g + col), g1 = *(const f32x4*)(E.g + col + 4), b0 = *(const f32x4*)(E.b + col), b1 = *(const f32x4*)(E.b + col + 4);
        const f32x4 y0 = (v0 - mean) * rstd * g0 + b0, y1 = (v1 - mean) * rstd * g1 + b1;
        u32x4 w; w.x = pk2(y0[0], y0[1]); w.y = pk2(y0[2], y0[3]); w.z = pk2(y1[0], y1[1]); w.w = pk2(y1[2], y1[3]);
        for (int bb = 0; bb < NB; ++bb) {
            const size_t o = (size_t)(bb * LP + PADR + i16) * D + col;
            *(f32x4*)(E.HF + o) = y0; *(f32x4*)(E.HF + o + 4) = y1;
            *(u32x4*)(E.HB + o) = w;
        }
    }
    __syncthreads();
}

DI int win_dst_row(int sc) {
    if (sc < 4096) { const int g = sc & ~63, j = sc & 63; return g + ((j & 31) << 1) + (j >> 5); }
    if (sc >= C_RQ && sc < C_RV) { const int g = sc & ~127, j = sc & 127; return g + ((j & 63) << 1) + (j >> 6); }
    return sc;
}
template <bool PERMW> DI void transpose_convert(const float* __restrict__ src, bf16_t* __restrict__ dst, int K, int N) {
    const int tid = opaque_tid(), wid = tid >> 6, lane = tid & 63;
    const int ntn = N / 64, ntk = (K + 255) / 256, ntile = ntn * ntk;
    for (int t = blockIdx.x; t < ntile; t += gridDim.x) {
        const int tn = t / ntk, tk = t % ntk;
        const int s4 = tn * 64 + (lane & 15) * 4, kb = tk * 256 + (wid * 4 + (lane >> 4)) * 8;
        if (kb < K) {
            f32x4 v[8];
#pragma unroll
            for (int j = 0; j < 8; ++j) v[j] = *(const f32x4*)(src + (size_t)(kb + j) * N + s4);
#pragma unroll
            for (int e = 0; e < 4; ++e) {
                const int n = PERMW ? win_dst_row(s4 + e) : (s4 + e);
                u32x4 w; w.x = pk2(v[0][e], v[1][e]); w.y = pk2(v[2][e], v[3][e]); w.z = pk2(v[4][e], v[5][e]); w.w = pk2(v[6][e], v[7][e]);
                *(u32x4*)(dst + (size_t)n * K + kb) = w;
            }
        }
    }
}

struct CvtTile { const float* src; bf16_t* dst; int K, N, t, ldd; bool perm; };
DI void cvt_load(const CvtTile& c, f32x4 (&v)[8], int& s4, int& kb, int wid, int lane) {
    const int ntk = (c.K + 255) / 256;
    const int tn = c.t / ntk, tk = c.t % ntk;
    s4 = tn * 64 + (lane & 15) * 4; kb = tk * 256 + (wid * 4 + (lane >> 4)) * 8;
    if (kb < c.K) {
#pragma unroll
        for (int j = 0; j < 8; ++j) v[j] = __builtin_nontemporal_load((const f32x4*)(c.src + (size_t)(kb + j) * c.N + s4));
    }
}
DI void cvt_store(const CvtTile& c, const f32x4 (&v)[8], int s4, int kb) {
    if (kb < c.K) {
#pragma unroll
        for (int e = 0; e < 4; ++e) {
            const int n = c.perm ? win_dst_row(s4 + e) : (s4 + e);
            u32x4 w; w.x = pk2(v[0][e], v[1][e]); w.y = pk2(v[2][e], v[3][e]); w.z = pk2(v[4][e], v[5][e]); w.w = pk2(v[6][e], v[7][e]);
            *(u32x4*)(c.dst + (size_t)n * c.ldd + kb) = w;
        }
    }
}
constexpr int CT_SQ = 32 * 8, CT_UP = 172 * 8, CT_DN = 32 * 22, CT_IN = 256 * 8;
constexpr int CT_L0 = 3 * CT_SQ + CT_UP + CT_DN, CT_TOTAL = 2 * CT_L0 + CT_IN, CT_PER_ITEM = 16, CT_ITEMS = (CT_TOTAL + CT_PER_ITEM - 1) / CT_PER_ITEM;
DI CvtTile deferred_tile(unsigned char* ws, int t) {
    CvtTile c; c.perm = false; c.ldd = 0;
    int l = 0;
    if (t >= CT_L0) { t -= CT_L0; l = 1;
        if (t < CT_IN) { c.src = argp(ws, 4) + (size_t)D * WIN; c.dst = (bf16_t*)(ws + WS_WIN + SZ_WIN); c.K = D; c.N = WIN; c.t = t; c.ldd = D; c.perm = true; return c; }
        t -= CT_IN; }
    if (t < CT_SQ) { c.src = argp(ws, 11) + (size_t)l * D * D; c.dst = (bf16_t*)(ws + WS_WA + l * 2 * SZ_SQ); c.K = D; c.N = D; c.t = t; c.ldd = 2 * D; return c; }
    t -= CT_SQ;
    if (t < CT_SQ) { c.src = argp(ws, 12) + (size_t)l * D * D; c.dst = (bf16_t*)(ws + WS_WA + l * 2 * SZ_SQ) + D; c.K = D; c.N = D; c.t = t; c.ldd = 2 * D; return c; }
    t -= CT_SQ;
    if (t < CT_SQ) { c.src = argp(ws, 13) + (size_t)l * D * D; c.dst = (bf16_t*)(ws + WS_WO + l * SZ_SQ); c.K = D; c.N = D; c.t = t; c.ldd = D; return c; }
    t -= CT_SQ;
    if (t < CT_UP) { c.src = argp(ws, 16) + (size_t)l * D * DFF2; c.dst = (bf16_t*)(ws + WS_WUP + l * SZ_WUP); c.K = D; c.N = DFF2; c.t = t; c.ldd = D; return c; }
    t -= CT_UP;
    c.src = argp(ws, 19) + (size_t)l * DFF * D; c.dst = (bf16_t*)(ws + WS_WDN + l * SZ_WDN); c.K = DFF; c.N = D; c.t = t; c.ldd = DFF; return c;
}
DI void convert_deferred_item(unsigned char* ws, int item) {
    const int tid = opaque_tid(), wid = tid >> 6, lane = tid & 63;
    const int t0 = item * CT_PER_ITEM;
#pragma nounroll
    for (int t = t0; t < t0 + CT_PER_ITEM; t += 4) {
        if (t >= CT_TOTAL) break;
        CvtTile c[4]; f32x4 v[4][8]; int s4[4], kb[4];
#pragma unroll
        for (int q = 0; q < 4; ++q) { c[q] = deferred_tile(ws, (t + q < CT_TOTAL) ? t + q : t); }
#pragma unroll
        for (int q = 0; q < 4; ++q) if (t + q < CT_TOTAL) cvt_load(c[q], v[q], s4[q], kb[q], wid, lane);
#pragma unroll
        for (int q = 0; q < 4; ++q) if (t + q < CT_TOTAL) cvt_store(c[q], v[q], s4[q], kb[q]);
    }
}

DI void ln_row(f32x4 (&x)[8], const float* __restrict__ g, const float* __restrict__ b, int lane) {
    float s = 0.f;
#pragma unroll
    for (int j = 0; j < 8; ++j) s += x[j][0] + x[j][1] + x[j][2] + x[j][3];
    const float mu = wave_sum(s) * (1.0f / D);
    float q = 0.f;
#pragma unroll
    for (int j = 0; j < 8; ++j) {
#pragma unroll
        for (int e = 0; e < 4; ++e) { const float d = x[j][e] - mu; q += d * d; }
    }
    const float rstd = rsqrtf(wave_sum(q) * (1.0f / D) + EPS);
#pragma unroll
    for (int j = 0; j < 8; ++j) { const int c = (j * 64 + lane) * 4; const f32x4 gv = *(const f32x4*)(g + c), bv = *(const f32x4*)(b + c);
#pragma unroll
        for (int e = 0; e < 4; ++e) x[j][e] = (x[j][e] - mu) * rstd * gv[e] + bv[e]; }
}
DI void store_h(const f32x4 (&x)[8], float* HF, bf16_t* HB, int row, int lane) {
#pragma unroll
    for (int j = 0; j < 8; ++j) { const int c = (j * 64 + lane) * 4;
        *(f32x4*)(HF + (size_t)row * D + c) = x[j];
        u32x2 w; w.x = pk2(x[j][0], x[j][1]); w.y = pk2(x[j][2], x[j][3]);
        *(u32x2*)(HB + (size_t)row * D + c) = w; }
}

template <int VT> DI void attn_pv2(f32x16& oa, f32x16& ob, unsigned vb, const bf16x8 (&pf)[2][2]) {
    const s16x4 al00 = tr_read<(0) * 320 + VT * 64>(vb), ah00 = tr_read<(8) * 320 + VT * 64>(vb);
    const s16x4 al01 = tr_read<(16) * 320 + VT * 64>(vb), ah01 = tr_read<(24) * 320 + VT * 64>(vb);
    const s16x4 al10 = tr_read<(32) * 320 + VT * 64>(vb), ah10 = tr_read<(40) * 320 + VT * 64>(vb);
    const s16x4 al11 = tr_read<(48) * 320 + VT * 64>(vb), ah11 = tr_read<(56) * 320 + VT * 64>(vb);
    const s16x4 bl00 = tr_read<(0) * 320 + VT * 64 + 64>(vb), bh00 = tr_read<(8) * 320 + VT * 64 + 64>(vb);
    const s16x4 bl01 = tr_read<(16) * 320 + VT * 64 + 64>(vb), bh01 = tr_read<(24) * 320 + VT * 64 + 64>(vb);
    const s16x4 bl10 = tr_read<(32) * 320 + VT * 64 + 64>(vb), bh10 = tr_read<(40) * 320 + VT * 64 + 64>(vb);
    const s16x4 bl11 = tr_read<(48) * 320 + VT * 64 + 64>(vb), bh11 = tr_read<(56) * 320 + VT * 64 + 64>(vb);
    LGKM0();
    oa = MFMA32(PK8(al00, ah00), pf[0][0], oa); ob = MFMA32(PK8(bl00, bh00), pf[0][0], ob);
    oa = MFMA32(PK8(al01, ah01), pf[0][1], oa); ob = MFMA32(PK8(bl01, bh01), pf[0][1], ob);
    oa = MFMA32(PK8(al10, ah10), pf[1][0], oa); ob = MFMA32(PK8(bl10, bh10), pf[1][0], ob);
    oa = MFMA32(PK8(al11, ah11), pf[1][1], oa); ob = MFMA32(PK8(bl11, bh11), pf[1][1], ob);
}
constexpr int AK_STR = 272, AV_STR = 320, AK_BUF = 64 * AK_STR, AV_BUF = 64 * AV_STR, AV_BASE = 2 * AK_BUF;
struct AttnCtx { int r, h, mp, qb, qrow; unsigned lds0, vlane; unsigned char* smem; };
DI void attn_S(f32x16 (&st)[2], const bf16x8 (&bq)[4], const AttnCtx& c, int kc) {
    bf16x8 kf[2][4];
    const unsigned char* kbase = c.smem + kc * AK_BUF + c.r * AK_STR + (c.mp * 64 + c.h * 8) * 2;
#pragma unroll
    for (int ksub = 0; ksub < 2; ++ksub)
#pragma unroll
        for (int ks = 0; ks < 4; ++ks) kf[ksub][ks] = *(const bf16x8*)(kbase + ksub * 32 * AK_STR + ks * 32);
#pragma unroll
    for (int i = 0; i < 16; ++i) { st[0][i] = 0.f; st[1][i] = 0.f; }
    LGKM0();
#pragma unroll
    for (int ks = 0; ks < 4; ++ks) { st[0] = MFMA32(kf[0][ks], bq[ks], st[0]); st[1] = MFMA32(kf[1][ks], bq[ks], st[1]); }
}
DI void attn_softmax(f32x16 (&st)[2], bf16x8 (&pf)[2][2], f32x16 (&ot)[4], float& mrun, float& lrun, const AttnCtx& c, int kt) {
    const float CS = 0.125f * 1.4426950408889634f;
    const bool need_mask = (kt < 2) || (kt >= 2 * c.qb);
#pragma unroll
    for (int ksub = 0; ksub < 2; ++ksub)
#pragma unroll
        for (int i = 0; i < 16; ++i) st[ksub][i] *= CS;
    if (need_mask) {
#pragma unroll
        for (int ksub = 0; ksub < 2; ++ksub)
#pragma unroll
            for (int i = 0; i < 16; ++i) {
                const int key = kt * 64 + ksub * 32 + crow(i, c.h);
                const bool ok = (key <= c.qrow) && (key >= PADR || key == c.qrow);
                st[ksub][i] = ok ? st[ksub][i] : -1e30f;
            }
    }
    float mx = -INFINITY;
#pragma unroll
    for (int ksub = 0; ksub < 2; ++ksub)
#pragma unroll
        for (int i = 0; i < 16; ++i) mx = fmaxf(mx, st[ksub][i]);
    mx = fmaxf(mx, shx(mx, 32));
    const bool raise = (mx - mrun) > 8.0f;
    const float mnew = raise ? mx : mrun;
    const float alpha = raise ? fexp2(mrun - mnew) : 1.0f;
    mrun = mnew;
    float ls = 0.f;
#pragma unroll
    for (int ksub = 0; ksub < 2; ++ksub)
#pragma unroll
        for (int i = 0; i < 16; ++i) { const float p = fexp2(st[ksub][i] - mnew); st[ksub][i] = p; ls += p; }
    lrun = lrun * alpha + ls;
    if (__builtin_amdgcn_ballot_w64(alpha != 1.0f) != 0ull) {
#pragma unroll
        for (int v = 0; v < 4; ++v)
#pragma unroll
            for (int i = 0; i < 16; ++i) ot[v][i] *= alpha;
    }
#pragma unroll
    for (int ksub = 0; ksub < 2; ++ksub)
#pragma unroll
        for (int s = 0; s < 2; ++s)
            pf[ksub][s] = pack8(st[ksub][8 * s], st[ksub][8 * s + 1], st[ksub][8 * s + 2], st[ksub][8 * s + 3], st[ksub][8 * s + 4], st[ksub][8 * s + 5], st[ksub][8 * s + 6], st[ksub][8 * s + 7]);
}
DI void attn_PV(f32x16 (&ot)[4], const bf16x8 (&pf)[2][2], const AttnCtx& c, int vc) {
    const unsigned vb = c.lds0 + AV_BASE + vc * AV_BUF + c.vlane;
    attn_pv2<0>(ot[0], ot[1], vb, pf); attn_pv2<2>(ot[2], ot[3], vb, pf);
}
DI void attn_item(const bf16_t* __restrict__ P, bf16_t* __restrict__ OA, const float* __restrict__ subg, float lam, float one_m_li,
                  int b, int hd, int qb, unsigned char* smem) {
    const int tid = opaque_tid(), wid = __builtin_amdgcn_readfirstlane(tid >> 6), lane = tid & 63, r = lane & 31, h = lane >> 5;
    const int mp = wid >> 2, qs = wid & 3;
    const bf16_t* Pb = P + (size_t)b * LP * PLD;
    const int qrow = qb * 128 + qs * 32 + r;
    bf16x8 bq[4];
#pragma unroll
    for (int ks = 0; ks < 4; ++ks) bq[ks] = *(const bf16x8*)(Pb + (size_t)qrow * PLD + C_AQ + hd * 128 + mp * 64 + ks * 16 + h * 8);
    f32x16 ot[4];
#pragma unroll
    for (int v = 0; v < 4; ++v)
#pragma unroll
        for (int i = 0; i < 16; ++i) ot[v][i] = 0.f;
    float mrun = -INFINITY, lrun = 0.f;
    const int kt0 = (qb >= 1) ? 1 : 0, kt1 = 2 * (qb + 1);
    u32x4 pk[2], pv[2];
    const int srow = tid >> 4, sc16 = tid & 15;
    const bf16_t* gsrc = Pb + (size_t)srow * PLD + hd * 128 + sc16 * 8;
#define A_GLOAD(kt) do { _Pragma("unroll") for (int _i = 0; _i < 2; ++_i) { const bf16_t* _s = gsrc + (size_t)((kt) * 64 + 32 * _i) * PLD; \
        pk[_i] = *(const u32x4*)(_s + C_AK); pv[_i] = *(const u32x4*)(_s + C_AV); } } while (0)
#define A_LSTORE(kbuf, vbuf, ktile) do { _Pragma("unroll") for (int _i = 0; _i < 2; ++_i) { \
        if ((ktile) < 2 && (ktile) * 64 + 32 * _i + srow < PADR) { pk[_i] = (u32x4){0u, 0u, 0u, 0u}; pv[_i] = (u32x4){0u, 0u, 0u, 0u}; }     \
        *(u32x4*)(smem + (kbuf) * AK_BUF + (srow + 32 * _i) * AK_STR + sc16 * 16) = pk[_i]; \
        *(u32x4*)(smem + AV_BASE + (vbuf) * AV_BUF + (srow + 32 * _i) * AV_STR + sc16 * 16) = pv[_i]; } } while (0)
    A_GLOAD(kt0); A_LSTORE(0, 0, kt0);
    __syncthreads();
    AttnCtx c; c.r = r; c.h = h; c.mp = mp; c.qb = qb; c.qrow = qrow; c.smem = smem; c.lds0 = (unsigned)(size_t)smem;
    c.vlane = (unsigned)((4 * h + ((lane >> 2) & 3)) * AV_STR + (16 * ((lane >> 4) & 1) + 4 * (lane & 3)) * 2);
    f32x16 st[2];
    bf16x8 pf[2][2];
    int kc = 0, vc = 0, vp = 2;
    if (mp == 0) {
        for (int kt = kt0; kt < kt1; ++kt) {
            const int vn = (vc == 2) ? 0 : vc + 1;
            if (kt + 1 < kt1) A_GLOAD(kt + 1);
            attn_S(st, bq, c, kc); attn_softmax(st, pf, ot, mrun, lrun, c, kt); attn_PV(ot, pf, c, vc);
            if (kt + 1 < kt1) A_LSTORE(kc ^ 1, vn, kt + 1);
            __syncthreads();
            kc ^= 1; vp = vc; vc = vn;
        }
    } else {
        for (int kt = kt0; kt < kt1; ++kt) {
            const int vn = (vc == 2) ? 0 : vc + 1;
            if (kt + 1 < kt1) A_GLOAD(kt + 1);
            if (kt > kt0) attn_PV(ot, pf, c, vp);
            attn_S(st, bq, c, kc); attn_softmax(st, pf, ot, mrun, lrun, c, kt);
            if (kt + 1 < kt1) A_LSTORE(kc ^ 1, vn, kt + 1);
            __syncthreads();
            kc ^= 1; vp = vc; vc = vn;
        }
        attn_PV(ot, pf, c, vp);
    }
#undef A_GLOAD
#undef A_LSTORE
    const float ltot = lrun + shx(lrun, 32);
    const float inv = 1.0f / ltot;
    float* X = (float*)smem;
    __syncthreads();
    if (mp == 1) {
#pragma unroll
        for (int v = 0; v < 4; ++v)
#pragma unroll
            for (int i = 0; i < 16; ++i) X[(qs * 64 + v * 16 + i) * 64 + lane] = ot[v][i] * inv;
    }
    __syncthreads();
    if (mp == 0) {
        float ss = 0.f;
#pragma unroll
        for (int v = 0; v < 4; ++v)
#pragma unroll
            for (int i = 0; i < 16; ++i) { const float o = ot[v][i] * inv - lam * X[(qs * 64 + v * 16 + i) * 64 + lane]; ot[v][i] = o; ss += o * o; }
        ss += shx(ss, 32);
        const float rs = rsqrtf(ss * (1.0f / 128.0f) + EPS) * one_m_li;
        bf16_t* orow = OA + (size_t)(b * LP + qrow) * (2 * D) + hd * 128;
#pragma unroll
        for (int v = 0; v < 4; ++v)
#pragma unroll
            for (int g4 = 0; g4 < 4; ++g4) {
                const int vc2 = 32 * v + 8 * g4 + 4 * h;
                const f32x4 gv = *(const f32x4*)(subg + vc2);
                u32x2 w; w.x = pk2(ot[v][4 * g4] * rs * gv[0], ot[v][4 * g4 + 1] * rs * gv[1]); w.y = pk2(ot[v][4 * g4 + 2] * rs * gv[2], ot[v][4 * g4 + 3] * rs * gv[3]);
                *(u32x2*)(orow + vc2) = w;
            }
    }
    __syncthreads();
}

constexpr int RV_STR = 576, RV_BYTES = 128 * RV_STR, RKA_STR = 320, RKC_STR = 272;
DI void ret_stage_v(const bf16_t* __restrict__ Pb, int c, int h8, unsigned char* smem) {
    const int tid = opaque_tid();
#pragma unroll
    for (int i = 0; i < 8; ++i) { const int p = tid + 512 * i, row = p >> 5, c16 = p & 31;
        u32x4 w = {0u, 0u, 0u, 0u};
        if (c > 0 || row >= PADR) w = *(const u32x4*)(Pb + (size_t)(c * 128 + row) * PLD + C_RV + h8 * 256 + c16 * 8);
        *(u32x4*)(smem + row * RV_STR + c16 * 16) = w; }
}
template <int S> DI void reta_step(f32x16 (&acc)[4], unsigned va0, unsigned ka0) {
    const unsigned va = va0 + (unsigned)(16 * S * RV_STR), ka = ka0 + (unsigned)(16 * S * RKA_STR);
    const s16x4 al = tr_read<0>(va), ah = tr_read<4 * RV_STR>(va);
    const s16x4 b0l = tr_read<0>(ka), b0h = tr_read<4 * RKA_STR + 0>(ka);
    const s16x4 b1l = tr_read<64>(ka), b1h = tr_read<4 * RKA_STR + 64>(ka);
    const s16x4 b2l = tr_read<128>(ka), b2h = tr_read<4 * RKA_STR + 128>(ka);
    const s16x4 b3l = tr_read<192>(ka), b3h = tr_read<4 * RKA_STR + 192>(ka);
    LGKM0();
    const bf16x8 a = PK8(al, ah);
    acc[0] = MFMA32(a, PK8(b0l, b0h), acc[0]);
    acc[1] = MFMA32(a, PK8(b1l, b1h), acc[1]);
    acc[2] = MFMA32(a, PK8(b2l, b2h), acc[2]);
    acc[3] = MFMA32(a, PK8(b3l, b3h), acc[3]);
}
DI void reta_item(const bf16_t* __restrict__ P, float* __restrict__ KVT, int b, int h8, int c, unsigned char* smem) {
    const int tid = opaque_tid(), wid = __builtin_amdgcn_readfirstlane(tid >> 6), lane = tid & 63, r = lane & 31, h = lane >> 5;
    const bf16_t* Pb = P + (size_t)b * LP * PLD;
    const float lg2 = __log2f(1.0f - fexp2(-5.0f - (float)h8));
    ret_stage_v(Pb, c, h8, smem);
#pragma unroll
    for (int i = 0; i < 4; ++i) { const int p = tid + 512 * i, row = p >> 4, c16 = p & 15;
        u32x4 w = {0u, 0u, 0u, 0u};
        if (c > 0 || row >= PADR) w = *(const u32x4*)(Pb + (size_t)(c * 128 + row) * PLD + C_RK + h8 * 128 + c16 * 8);
        const float d = fexp2(lg2 * (float)(127 - row));
        u32x4 o;
        o.x = pk2(bf2f(w.x & 0xffffu) * d, bf2f(w.x >> 16) * d); o.y = pk2(bf2f(w.y & 0xffffu) * d, bf2f(w.y >> 16) * d);
        o.z = pk2(bf2f(w.z & 0xffffu) * d, bf2f(w.z >> 16) * d); o.w = pk2(bf2f(w.w & 0xffffu) * d, bf2f(w.w >> 16) * d);
        *(u32x4*)(smem + RV_BYTES + row * RKA_STR + c16 * 16) = o; }
    __syncthreads();
    f32x16 acc[4];
#pragma unroll
    for (int t = 0; t < 4; ++t)
#pragma unroll
        for (int i = 0; i < 16; ++i) acc[t][i] = 0.f;
    const unsigned lds0 = (unsigned)(size_t)smem;
    const int qq = (lane >> 2) & 3, pp = lane & 3, blk = (lane >> 4) & 1;
    const unsigned va = lds0 + (unsigned)((8 * h + qq) * RV_STR + (32 * wid + 16 * blk + 4 * pp) * 2);
    const unsigned ka = lds0 + RV_BYTES + (unsigned)((8 * h + qq) * RKA_STR + (16 * blk + 4 * pp) * 2);
    reta_step<0>(acc, va, ka); reta_step<1>(acc, va, ka); reta_step<2>(acc, va, ka); reta_step<3>(acc, va, ka);
    reta_step<4>(acc, va, ka); reta_step<5>(acc, va, ka); reta_step<6>(acc, va, ka); reta_step<7>(acc, va, ka);
    __syncthreads();
    float* Lw = (float*)smem + wid * 4096;
#pragma unroll
    for (int t = 0; t < 4; ++t)
#pragma unroll
        for (int i = 0; i < 16; ++i) Lw[crow(i, h) * 128 + 32 * t + r] = acc[t][i];
    asm volatile("s_waitcnt lgkmcnt(0)" ::: "memory");
    float* dst = KVT + ((size_t)((b * 8 + h8) * 16 + c)) * 32768 + (size_t)(32 * wid) * 128;
    const int orow = lane >> 5, ocol = (lane & 31) * 4;
#pragma unroll
    for (int j = 0; j < 16; ++j) st16_wt(dst + (2 * j + orow) * 128 + ocol, *(const f32x4*)(Lw + (2 * j + orow) * 128 + ocol));
    __syncthreads();
}
template <int VT> DI void retc_pv(f32x16& o, unsigned vb, const bf16x8 (&pf)[2]) {
    const s16x4 l0 = tr_read<(0) * RV_STR + VT * 64>(vb), h0 = tr_read<(8) * RV_STR + VT * 64>(vb);
    const s16x4 l1 = tr_read<(16) * RV_STR + VT * 64>(vb), h1 = tr_read<(24) * RV_STR + VT * 64>(vb);
    LGKM0();
    o = MFMA32(PK8(l0, h0), pf[0], o);
    o = MFMA32(PK8(l1, h1), pf[1], o);
}
DI void retc_item(const bf16_t* __restrict__ P, const bf16_t* __restrict__ PREVT, bf16_t* __restrict__ OR_, const float* __restrict__ gng,
                  int b, int h8, int c, unsigned char* smem) {
    const int tid = opaque_tid(), wid = __builtin_amdgcn_readfirstlane(tid >> 6), lane = tid & 63, r = lane & 31, h = lane >> 5;
    const int nb = wid & 3, dh = wid >> 2;
    const bf16_t* Pb = P + (size_t)b * LP * PLD;
    const float lg2 = __log2f(1.0f - fexp2(-5.0f - (float)h8));
    u32x4 rv[8], rk[4];
#pragma unroll
    for (int i = 0; i < 8; ++i) { const int p = tid + 512 * i, row = p >> 5, c16 = p & 31;
        rv[i] = (u32x4){0u, 0u, 0u, 0u};
        if (c > 0 || row >= PADR) rv[i] = *(const u32x4*)(Pb + (size_t)(c * 128 + row) * PLD + C_RV + h8 * 256 + c16 * 8); }
#pragma unroll
    for (int i = 0; i < 4; ++i) { const int p = tid + 512 * i, row = p >> 4, c16 = p & 15;
        rk[i] = (u32x4){0u, 0u, 0u, 0u};
        if (c > 0 || row >= PADR) rk[i] = *(const u32x4*)(Pb + (size_t)(c * 128 + row) * PLD + C_RK + h8 * 128 + c16 * 8); }
    const int nloc = 32 * nb + r;
    const int grow = b * LP + c * 128 + nloc;
    bf16x8 bq[8];
#pragma unroll
    for (int ks = 0; ks < 8; ++ks) bq[ks] = *(const bf16x8*)(P + (size_t)grow * PLD + C_RQ + h8 * 128 + ks * 16 + h * 8);
    f32x16 acc[4];
    const bf16_t* pv = PREVT + ((size_t)((b * 8 + h8) * 17 + c)) * 32768 + (size_t)(128 * dh + r) * 128 + h * 8;
    bf16x8 pa[2][8];
#pragma unroll
    for (int ks = 0; ks < 8; ++ks) pa[0][ks] = *(const bf16x8*)(pv + ks * 16);
#pragma unroll
    for (int v = 0; v < 4; ++v) {
        if (v + 1 < 4) {
#pragma unroll
            for (int ks = 0; ks < 8; ++ks) pa[(v + 1) & 1][ks] = *(const bf16x8*)(pv + (size_t)(32 * (v + 1)) * 128 + ks * 16);
        }
#pragma unroll
        for (int i = 0; i < 16; ++i) acc[v][i] = 0.f;
#pragma unroll
        for (int ks = 0; ks < 8; ++ks) acc[v] = MFMA32(pa[v & 1][ks], bq[ks], acc[v]);
    }
#pragma unroll
    for (int i = 0; i < 8; ++i) { const int p = tid + 512 * i, row = p >> 5, c16 = p & 31; *(u32x4*)(smem + row * RV_STR + c16 * 16) = rv[i]; }
#pragma unroll
    for (int i = 0; i < 4; ++i) { const int p = tid + 512 * i, row = p >> 4, c16 = p & 15; *(u32x4*)(smem + RV_BYTES + row * RKC_STR + c16 * 16) = rk[i]; }
    __syncthreads();
    const float dq = fexp2(lg2 * (float)(nloc + 1));
#pragma unroll
    for (int v = 0; v < 4; ++v)
#pragma unroll
        for (int i = 0; i < 16; ++i) acc[v][i] *= dq;
    const unsigned lds0 = (unsigned)(size_t)smem;
    const int qq = (lane >> 2) & 3, pp = lane & 3, blk = (lane >> 4) & 1;
    for (int mt = 0; mt <= nb; ++mt) {
        f32x16 st;
#pragma unroll
        for (int i = 0; i < 16; ++i) st[i] = 0.f;
#pragma unroll
        for (int ks = 0; ks < 8; ++ks) {
            const bf16x8 a = *(const bf16x8*)(smem + RV_BYTES + (32 * mt + r) * RKC_STR + (ks * 16 + h * 8) * 2);
            st = MFMA32(a, bq[ks], st);
        }
#pragma unroll
        for (int i = 0; i < 16; ++i) { const int dd = nloc - (32 * mt + crow(i, h)); st[i] = (dd >= 0) ? st[i] * fexp2(lg2 * (float)dd) : 0.f; }
        bf16x8 pf[2];
        pf[0] = pack8(st[0], st[1], st[2], st[3], st[4], st[5], st[6], st[7]);
        pf[1] = pack8(st[8], st[9], st[10], st[11], st[12], st[13], st[14], st[15]);
        const unsigned vb = lds0 + (unsigned)((32 * mt + 4 * h + qq) * RV_STR + (128 * dh + 16 * blk + 4 * pp) * 2);
        retc_pv<0>(acc[0], vb, pf); retc_pv<1>(acc[1], vb, pf); retc_pv<2>(acc[2], vb, pf); retc_pv<3>(acc[3], vb, pf);
    }
    float s1 = 0.f, s2 = 0.f;
#pragma unroll
    for (int v = 0; v < 4; ++v)
#pragma unroll
        for (int i = 0; i < 16; ++i) { s1 += acc[v][i]; s2 += acc[v][i] * acc[v][i]; }
    s1 += shx(s1, 32); s2 += shx(s2, 32);
    float* ST = (float*)(smem + RV_BYTES + 128 * RKC_STR);
    if (h == 0) { ST[(dh * 128 + nloc) * 2] = s1; ST[(dh * 128 + nloc) * 2 + 1] = s2; }
    __syncthreads();
    const float t1 = ST[nloc * 2] + ST[(128 + nloc) * 2], t2 = ST[nloc * 2 + 1] + ST[(128 + nloc) * 2 + 1];
    const float mu = t1 * (1.0f / 256.0f);
    const float var = fmaxf(t2 * (1.0f / 256.0f) - mu * mu, 0.f);
    const float rstd = rsqrtf(var + EPS);
#pragma unroll
    for (int v = 0; v < 4; ++v)
#pragma unroll
        for (int g4 = 0; g4 < 4; ++g4) {
            const int col = h8 * 256 + 128 * dh + 32 * v + 8 * g4 + 4 * h;
            const f32x4 gv = *(const f32x4*)(gng + col);
            const u32x2 sw = *(const u32x2*)(P + (size_t)grow * PLD + C_RG + col);
            const float y0 = (acc[v][4 * g4] - mu) * rstd * gv[0] * bf2f(sw.x & 0xffffu);
            const float y1 = (acc[v][4 * g4 + 1] - mu) * rstd * gv[1] * bf2f(sw.x >> 16);
            const float y2 = (acc[v][4 * g4 + 2] - mu) * rstd * gv[2] * bf2f(sw.y & 0xffffu);
            const float y3 = (acc[v][4 * g4 + 3] - mu) * rstd * gv[3] * bf2f(sw.y >> 16);
            u32x2 w; w.x = pk2(y0, y1); w.y = pk2(y2, y3);
            *(u32x2*)(OR_ + (size_t)grow * (2 * D) + col) = w;
        }
    __syncthreads();
}

__global__ void __launch_bounds__(512, 2) fwd_megakernel(Params prm) {
    extern __shared__ __attribute__((aligned(16))) unsigned char smem[];
    cg::grid_group grid = cg::this_grid();
    unsigned epoch = 0;
    unsigned char* ws = prm.ws;
#define WSP(T, OFF) ((T*)(wsl(ws) + (OFF)))
#define BAR WSP(unsigned, WS_BAR)
#define GSYNC() xcd_barrier(xb)
    const int tid = threadIdx.x, wid = tid >> 6, lane = tid & 63;
#define LAM WSP(float, WS_LAM)
#define TA WSP(float, WS_TA)
#define TR WSP(float, WS_TR)
#define HF WSP(float, WS_HF)
#define HB WSP(bf16_t, WS_HB)
#define P WSP(bf16_t, WS_P)
#define U WSP(bf16_t, WS_P)
#define OA WSP(bf16_t, WS_OA)
#define OR_ (WSP(bf16_t, WS_OA) + D)
#define MG WSP(bf16_t, WS_MG)
#define PREVT WSP(bf16_t, WS_MG)
#define ACT WSP(bf16_t, WS_ACT)
#define KVT WSP(float, WS_ACT)
    LAS unsigned char* lds = (LAS unsigned char*)smem;
    volatile LAS unsigned* xst = (volatile LAS unsigned*)(lds + LDS_MISC + 16);
    if (threadIdx.x == 0) { xst[0] = 0u; xst[1] = 0u; }
    __syncthreads();
    const XcdBarrier xb = xcd_barrier_post((unsigned*)(prm.ws + WS_XB), xst);
    const int gw = blockIdx.x * 8 + wid, nw = gridDim.x * 8;

    transpose_convert<true>(prm.in[4], (bf16_t*)(ws + WS_WIN), D, WIN);
    for (int i = blockIdx.x * 512 + tid; i < LP * 96; i += gridDim.x * 512) {
        const int l = i / 96, j = i % 96; const float pos = (float)(l - PADR);
        float f; float* dst;
        if (j < 32) { f = 1.0f / powf(10000.0f, (float)(2 * j) / 64.0f); dst = TA + ((size_t)l * 32 + j) * 2; }
        else { const int jj = j - 32; f = 1.0f / powf(10000.0f, (float)jj / 63.0f); dst = TR + ((size_t)l * 64 + jj) * 2; }
        const float ang = pos * f;
        dst[0] = (float)cos((double)ang); dst[1] = (float)sin((double)ang);
    }
    if (tid < 23) ((const float**)(ws + WS_TAB))[tid] = (tid < 22) ? prm.in[tid] : (const float*)prm.out;
    if (blockIdx.x == 0 && tid < 2) {
        const int l = tid; float s1 = 0.f, s2 = 0.f;
        for (int i = 0; i < 64; ++i) { s1 += prm.in[5][l * 64 + i] * prm.in[6][l * 64 + i]; s2 += prm.in[7][l * 64 + i] * prm.in[8][l * 64 + i]; }
        const float li = 0.8f - 0.6f * expf(-0.3f * (float)l);
        LAM[l] = expf(s1) - expf(s2) + li;
    }
    for (int row = gw; row < MROWS; row += nw) {
        const int b = row / LP, l = row % LP;
        if (l < PADR) continue;
        f32x4 x[8];
        {
            const float* src = (l < 128) ? prm.in[1] + (size_t)(l - PADR) * D : prm.in[0] + ((size_t)b * SEQ + (l - 128)) * D;
#pragma unroll
            for (int j = 0; j < 8; ++j) x[j] = *(const f32x4*)(src + (j * 64 + lane) * 4);
        }
        ln_row(x, prm.in[2], prm.in[3], lane);
        store_h(x, HF, HB, row, lane);
    }
    GSYNC();
    if (gridDim.x == 0x7fffffffu) grid.sync();

#pragma nounroll
    for (int layer = 0; layer < 2; ++layer) {
        const float lam_init = 0.8f - 0.6f * expf(-0.3f * (float)layer);
        for (int rep = 0; rep < REP_INPROJ; ++rep)
        {
            pg8::Gemm g{HB, (const bf16_t*)(ws + WS_WIN + layer * SZ_WIN), MROWS, WIN, D};
            pg8::StaticOrder S; S.init(NB * SEQ, WIN, gridDim.x, blockIdx.x);
            EpiIn E{P, TA, TR};
            pg8::gemm_phase(lds, g, S, E);
            meta_gemm(g.A, g.Bt, WIN, D, E, smem);
        }
        GSYNC();
        for (int rep = 0; rep < REP_ATTN; ++rep)
        {
            const float lam = LAM[layer];
            volatile int* sidx = (volatile int*)(smem + LDS_MISC);
            const int qt = opaque_tid();
            const int grp = blockIdx.x & 7;
            unsigned* qbase = (unsigned*)(ws + WS_QCTR);
            unsigned* qctr = qbase + 16 * (layer * 8 + grp) + 256 * rep;
            unsigned* pa_done = qbase + 512 + layer * 32;
            unsigned* sc_done = qbase + 576 + layer * 32;
            for (;;) {
                if (qt == 0) *sidx = (int)atomicAdd(qctr, 1u);
                __syncthreads();
                const int idx = __builtin_amdgcn_readfirstlane(*sidx);
                __syncthreads();
                const int NC = (layer == 0) ? ((CT_ITEMS - grp + 7) >> 3) : 0;
                if (idx >= 300 + NC) break;
                if (idx < 64) {
                    const int bh = grp + 8 * (idx >> 4), c = idx & 15;
                    reta_item(P, KVT, bh >> 3, bh & 7, c, smem);
                    item_signal_wt(pa_done + bh);
                } else if (idx < 96) {
                    const int j = idx - 64, bh = grp + 8 * (j >> 3), part = j & 7, h8 = bh & 7;
                    item_wait(pa_done + bh, 16u);
                    const int off = part * 4096 + qt * 8;
                    const float cd = fexp2(128.0f * __log2f(1.0f - fexp2(-5.0f - (float)h8)));
                    float sst[8]; float zz = 0.f; asm volatile("" : "+v"(zz));
#pragma unroll
                    for (int e = 0; e < 8; ++e) sst[e] = zz;
#pragma unroll 4
                    for (int c = 0; c < 17; ++c) {
                        u32x4 w; w.x = pk2(sst[0], sst[1]); w.y = pk2(sst[2], sst[3]); w.z = pk2(sst[4], sst[5]); w.w = pk2(sst[6], sst[7]);
                        st16_wt(PREVT + ((size_t)(bh * 17 + c)) * 32768 + off, w);
                        if (c < 16) {
                            const float* kp = KVT + ((size_t)(bh * 16 + c)) * 32768 + off;
                            const f32x4 k0 = *(const f32x4*)kp, k1 = *(const f32x4*)(kp + 4);
#pragma unroll
                            for (int e = 0; e < 4; ++e) { sst[e] = cd * sst[e] + k0[e]; sst[4 + e] = cd * sst[4 + e] + k1[e]; }
                        }
                    }
                    item_signal_wt(sc_done + bh);
                } else if (idx < 232 + NC) {
                    const int p = idx - 96;
                    int ai = -1, ci = -1;
                    if (p < 3 * NC) { if (p % 3 == 2) ci = p / 3; else ai = p - p / 3; } else ai = p - NC;
                    if (ai >= 136) { ci = NC - 1 - (ai - 136); ai = -1; }
                    if (ci >= 0) {
                        const int item = grp + 8 * ci;
                        convert_deferred_item(ws, item);
                    } else {
                        const int bh = grp + 8 * (ai / 17), qb = 16 - (ai % 17);
                        attn_item(P, OA, argp(ws, 9) + layer * 128, lam, 1.0f - lam_init, bh >> 4, bh & 15, qb, smem);
                    }
                } else {
                    const int j = idx - 232 - NC; const int bh = grp + 8 * (j / 17), c = j % 17;
                    item_wait(sc_done + bh, 8u);
                    retc_item(P, PREVT, OR_, argp(ws, 10) + layer * D, bh >> 3, bh & 7, c, smem);
                }
            }
        }
        GSYNC();
        {
            pg8::StaticOrder S; S.init(NB * SEQ, D, gridDim.x, blockIdx.x);
            pg8::Gemm g{OA, (const bf16_t*)(ws + WS_WA + layer * 2 * SZ_SQ), MROWS, D, 2 * D};
            EpiMerge E{P, MG};
            pg8::gemm_phase(lds, g, S, E);
            meta_gemm_merge(g.A, g.Bt, E, smem);
        }
        GSYNC();
        {
            pg8::StaticOrder S; S.init(NB * SEQ, D, gridDim.x, blockIdx.x);
            pg8::Gemm g{MG, (const bf16_t*)(ws + WS_WO + layer * SZ_SQ), MROWS, D, D};
            EpiLN E{HF, HB, nullptr, argp(ws, 14) + layer * D, argp(ws, 15) + layer * D, (float*)(ws + WS_STATS), (unsigned*)(ws + WS_LNCNT) + (layer * 2 + 0) * 64, smem};
            pg8::gemm_phase(lds, g, S, E);
            meta_gemm_ln(g.A, g.Bt, D, E, smem);
        }
        GSYNC();
        {
            pg8::StaticOrder S; S.init(NB * SEQ, DFF2, gridDim.x, blockIdx.x);
            pg8::Gemm g{HB, (const bf16_t*)(ws + WS_WUP + layer * SZ_WUP), MROWS, DFF2, D};
            EpiUp E{U};
            pg8::gemm_phase(lds, g, S, E);
            meta_gemm(g.A, g.Bt, DFF2, D, E, smem);
        }
        GSYNC();
        for (int rep = 0; rep < REP_MISC; ++rep)
        {
            const float* cw = argp(ws, 17) + (size_t)layer * 3 * DFF2; const float* cb = argp(ws, 18) + (size_t)layer * DFF2;
            const int ctid = opaque_tid();
            for (int idx = blockIdx.x * 512 + ctid; idx < NB * 129 * (DFF / 8); idx += gridDim.x * 512) {
                const int rbi = idx / (DFF / 8), j = (idx % (DFF / 8)) * 8;
                const int b = rbi / 129, l0 = PADR + (rbi % 129) * 16;
                const bf16_t* up = U + (size_t)(b * LP + l0) * DFF2 + j;
                float w[2][3][8], bs[2][8];
#pragma unroll
                for (int q = 0; q < 2; ++q) {
#pragma unroll
                    for (int t = 0; t < 3; ++t) { const f32x4 a0 = *(const f32x4*)(cw + (size_t)t * DFF2 + q * DFF + j), a1 = *(const f32x4*)(cw + (size_t)t * DFF2 + q * DFF + j + 4);
#pragma unroll
                        for (int e = 0; e < 4; ++e) { w[q][t][e] = a0[e]; w[q][t][4 + e] = a1[e]; } }
                    const f32x4 c0 = *(const f32x4*)(cb + q * DFF + j), c1 = *(const f32x4*)(cb + q * DFF + j + 4);
#pragma unroll
                    for (int e = 0; e < 4; ++e) { bs[q][e] = c0[e]; bs[q][4 + e] = c1[e]; }
                }
                u32x4 h2[2], h1[2];
#pragma unroll
                for (int q = 0; q < 2; ++q) {
                    h2[q] = (u32x4){0u, 0u, 0u, 0u}; h1[q] = (u32x4){0u, 0u, 0u, 0u};
                    if (l0 > PADR) { h2[q] = *(const u32x4*)(up - 2 * (size_t)DFF2 + q * DFF); h1[q] = *(const u32x4*)(up - (size_t)DFF2 + q * DFF); }
                }
#pragma unroll 4
                for (int t = 0; t < 16; ++t) {
                    u32x4 h0[2];
#pragma unroll
                    for (int q = 0; q < 2; ++q) h0[q] = *(const u32x4*)(up + (size_t)t * DFF2 + q * DFF);
                    float c[2][8];
#pragma unroll
                    for (int q = 0; q < 2; ++q) {
#pragma unroll
                        for (int e2 = 0; e2 < 4; ++e2) {
                            const unsigned x2 = h2[q][e2], x1 = h1[q][e2], x0 = h0[q][e2];
                            c[q][2 * e2] = bs[q][2 * e2] + w[q][0][2 * e2] * bf2f(x2 & 0xffffu) + w[q][1][2 * e2] * bf2f(x1 & 0xffffu) + w[q][2][2 * e2] * bf2f(x0 & 0xffffu);
                            c[q][2 * e2 + 1] = bs[q][2 * e2 + 1] + w[q][0][2 * e2 + 1] * bf2f(x2 >> 16) + w[q][1][2 * e2 + 1] * bf2f(x1 >> 16) + w[q][2][2 * e2 + 1] * bf2f(x0 >> 16);
                        }
                        h2[q] = h1[q]; h1[q] = h0[q];
                    }
                    float a[8];
#pragma unroll
                    for (int e = 0; e < 8; e += 2) { const f32x2 gg = gelu_pk((f32x2){c[0][e], c[0][e + 1]}); a[e] = gg.x * c[1][e]; a[e + 1] = gg.y * c[1][e + 1]; }
                    u32x4 o; o.x = pk2(a[0], a[1]); o.y = pk2(a[2], a[3]); o.z = pk2(a[4], a[5]); o.w = pk2(a[6], a[7]);
                    *(u32x4*)(ACT + (size_t)(b * LP + l0 + t) * DFF + j) = o;
                }
            }
        }
        GSYNC();
        {
            pg8::StaticOrder S; S.init(NB * SEQ, D, gridDim.x, blockIdx.x);
            pg8::Gemm g{ACT, (const bf16_t*)(ws + WS_WDN + layer * SZ_WDN), MROWS, D, DFF};
            EpiLN E{HF, HB, (layer == 1) ? (float*)argp(ws, 22) : nullptr, argp(ws, 20) + layer * D, argp(ws, 21) + layer * D, (float*)(ws + WS_STATS), (unsigned*)(ws + WS_LNCNT) + (layer * 2 + 1) * 64, smem};
            pg8::gemm_phase(lds, g, S, E);
            if (layer == 0) meta_gemm_ln(g.A, g.Bt, DFF, E, smem);
        }
        if (layer == 0) GSYNC();
    }
}

extern "C" void kernel_launch(void* const* d_in, const int* in_sizes, int n_in, void* d_out, int out_size, void* d_ws, size_t ws_size, hipStream_t stream) {
    static int grid_blocks = 0;
    if (!grid_blocks) {
        if (n_in != 22 || ws_size < WS_END) { fprintf(stderr, "kernel_launch: unexpected n_in %d or ws %zu < %zu\n", n_in, ws_size, (size_t)WS_END); grid_blocks = -1; return; }
        int dev = 0, cus = 0, per_cu = 0;
        hipGetDevice(&dev);
        hipDeviceGetAttribute(&cus, hipDeviceAttributeMultiprocessorCount, dev);
        if (hipFuncSetAttribute((const void*)fwd_megakernel, hipFuncAttributeMaxDynamicSharedMemorySize, LDS_BYTES) != hipSuccess) fprintf(stderr, "kernel_launch: hipFuncSetAttribute failed\n");
        if (hipOccupancyMaxActiveBlocksPerMultiprocessor(&per_cu, (const void*)fwd_megakernel, 512, LDS_BYTES) != hipSuccess || per_cu < 1) { fprintf(stderr, "kernel_launch: occupancy query gave %d\n", per_cu); per_cu = 1; }
        (void)hipGetLastError();
        grid_blocks = cus * (per_cu > 1 ? 1 : per_cu);
        if (grid_blocks > 256) grid_blocks = 256;
        if (grid_blocks != 256) { fprintf(stderr, "kernel_launch: this kernel needs exactly 256 resident workgroups (got %d); nothing launched\n", grid_blocks); grid_blocks = -1; return; }
    }
    if (grid_blocks < 0) return;
    (void)hipMemsetAsync((char*)d_ws + WS_CTR, 0, WS_TA, stream);
    Params p{};
    for (int i = 0; i < 22; ++i) p.in[i] = (const float*)d_in[i];
    p.out = (float*)d_out; p.ws = (unsigned char*)d_ws;
    void* args[] = {&p};
    hipError_t e = hipLaunchCooperativeKernel((const void*)fwd_megakernel, dim3(grid_blocks), dim3(512), args, LDS_BYTES, stream);
    if (e != hipSuccess) fprintf(stderr, "cooperative launch failed: %s (grid %d)\n", hipGetErrorString(e), grid_blocks);
}
```

```cpp
#include <hip/hip_runtime.h>
#include <hip/hip_cooperative_groups.h>
#include <cstdio>
namespace cg = cooperative_groups;

#define LAS __attribute__((address_space(3)))
#define DI __device__ __forceinline__
typedef unsigned short bf16_t;
typedef short bf16x8 __attribute__((ext_vector_type(8)));
typedef short s16x4 __attribute__((ext_vector_type(4)));
typedef float f32x2 __attribute__((ext_vector_type(2)));
typedef float f32x4 __attribute__((ext_vector_type(4)));
typedef float f32x16 __attribute__((ext_vector_type(16)));
typedef unsigned u32x2 __attribute__((ext_vector_type(2)));
typedef unsigned u32x4 __attribute__((ext_vector_type(4)));
typedef __bf16 bf2_t __attribute__((ext_vector_type(2)));

constexpr int D = 2048, NB = 4, LP = 2176, MROWS = NB * LP, PADR = 112, SEQ = 2048;
constexpr int WIN = 16384, DFF = 5504, DFF2 = 11008;
constexpr int PLD = WIN + 128;
constexpr float ALPHA = 1.41421356237f, EPS = 1e-5f;
constexpr int C_AQ = 0, C_AK = 2048, C_AV = 4096, C_RQ = 6144, C_RK = 7168, C_RV = 8192, C_RG = 10240, C_GA = 12288, C_GB = 14336;

constexpr size_t WS_CTR = 0;
constexpr size_t WS_LAM = 256;
constexpr size_t WS_BAR = 512;
constexpr size_t WS_QCTR = 512 + 5120;
constexpr size_t WS_LNCNT = 512 + 8192;
constexpr size_t WS_TAB = 512 + 8192 + 2048;
constexpr size_t WS_XB = 512 + 16384;
constexpr size_t WS_TA = 512 + 16384 + 16384;
constexpr size_t WS_TR = WS_TA + (size_t)LP * 32 * 2 * 4;
constexpr size_t WS_WIN = WS_TR + (size_t)LP * 64 * 2 * 4;
constexpr size_t SZ_WIN = (size_t)WIN * D * 2;
constexpr size_t WS_WA = WS_WIN + 2 * SZ_WIN;
constexpr size_t SZ_SQ = (size_t)D * D * 2;
constexpr size_t WS_WB = WS_WA + 2 * SZ_SQ;
constexpr size_t WS_WO = WS_WB + 2 * SZ_SQ;
constexpr size_t WS_WUP = WS_WO + 2 * SZ_SQ;
constexpr size_t SZ_WUP = (size_t)DFF2 * D * 2;
constexpr size_t WS_WDN = WS_WUP + 2 * SZ_WUP;
constexpr size_t SZ_WDN = (size_t)D * DFF * 2;
constexpr size_t WS_HF = WS_WDN + 2 * SZ_WDN;
constexpr size_t WS_HB = WS_HF + (size_t)MROWS * D * 4;
constexpr size_t WS_P = WS_HB + (size_t)MROWS * D * 2;
constexpr size_t WS_OA = WS_P + (size_t)MROWS * PLD * 2;
constexpr size_t WS_OR = WS_OA + (size_t)MROWS * D * 2;
constexpr size_t WS_MG = WS_OR + (size_t)MROWS * D * 2;
constexpr size_t WS_PRE = WS_MG + (size_t)MROWS * D * 2;
constexpr size_t WS_ACT = WS_PRE + (size_t)MROWS * D * 4;
constexpr size_t WS_STATS = WS_ACT + (size_t)MROWS * DFF * 2;
constexpr size_t WS_END = WS_STATS + (size_t)(32 * 8 * 256 + 64 * 16) * 8;

#define REP_P0 1
#define REP_INPROJ 1
#define REP_ATTN 1
#define REP_MISC 1
#ifndef PMASK
#define PMASK 0xffff
#endif
constexpr int LDS_BYTES = 131072 + 1024;
constexpr int LDS_MISC = 131072;

struct Params { const float* in[22]; float* out; unsigned char* ws; };

DI int opaque_tid() { int t = threadIdx.x; asm volatile("" : "+v"(t)); return t; }
DI float shx(float v, int mask) { const int l = opaque_tid() & 63; return __int_as_float(__builtin_amdgcn_ds_bpermute((l ^ mask) << 2, __float_as_int(v))); }
DI float bf2f(unsigned h) { return __uint_as_float(h << 16); }
DI unsigned pk2(float lo, float hi) { f32x2 v = {lo, hi}; bf2_t b = __builtin_convertvector(v, bf2_t); return __builtin_bit_cast(unsigned, b); }
DI bf16_t f2bf(float x) { return (bf16_t)(pk2(x, 0.f) & 0xffffu); }
DI float wave_sum(float v) { for (int o = 32; o; o >>= 1) v += shx(v, o); return v; }
DI int crow(int i, int h) { return (i & 3) + 8 * (i >> 2) + 4 * h; }
DI float fexp2(float x) { return __builtin_amdgcn_exp2f(x); }
DI float sigmoidf_(float x) { return __builtin_amdgcn_rcpf(1.0f + fexp2(-1.4426950408889634f * x)); }
#define MFMA32(a, b, c) __builtin_amdgcn_mfma_f32_32x32x16_bf16((a), (b), (c), 0, 0, 0)
template <int OFF> DI s16x4 tr_read(unsigned addr) { s16x4 r; asm volatile("ds_read_b64_tr_b16 %0, %1 offset:%2" : "=&v"(r) : "v"(addr), "i"(OFF) : "memory"); return r; }
#define LGKM0() do { asm volatile("s_waitcnt lgkmcnt(0)" ::: "memory"); __builtin_amdgcn_sched_barrier(0); } while (0)
#define PK8(L, H) (bf16x8){L[0], L[1], L[2], L[3], H[0], H[1], H[2], H[3]}
DI bf16x8 pack8(float a0, float a1, float a2, float a3, float a4, float a5, float a6, float a7) {
    u32x4 w; w.x = pk2(a0, a1); w.y = pk2(a2, a3); w.z = pk2(a4, a5); w.w = pk2(a6, a7); return __builtin_bit_cast(bf16x8, w);
}


DI unsigned ab_ld(unsigned* p) { return __hip_atomic_load(p, __ATOMIC_RELAXED, __HIP_MEMORY_SCOPE_AGENT); }
DI unsigned ab_add(unsigned* p, unsigned v) { return __hip_atomic_fetch_add(p, v, __ATOMIC_RELAXED, __HIP_MEMORY_SCOPE_AGENT); }
#define AB_SPIN(cond) do { unsigned _sp = 0; while (cond) { __builtin_amdgcn_s_sleep(1); if (++_sp > (1u << 24)) break; } } while (0)
DI void fast_barrier(unsigned* bar, unsigned epoch) {
    asm volatile("s_waitcnt vmcnt(0)" ::: "memory");
    __syncthreads();
    if (threadIdx.x == 0) {
        const unsigned G = gridDim.x, g = blockIdx.x & 7u, ng = (G - g + 7u) >> 3, ngroups = G < 8u ? G : 8u;
        __builtin_amdgcn_fence(__ATOMIC_RELEASE, "agent");
        asm volatile("s_waitcnt vmcnt(0)" ::: "memory");
        unsigned* sub = bar + 64 * (1 + g); unsigned* gen = bar + 64 * (9 + g); unsigned* top = bar + 64 * 17; unsigned* topgen = bar + 64 * 18;
        const unsigned old = ab_add(sub, 1u);
        if (old + 1u == epoch * ng) {
            const unsigned ot = ab_add(top, 1u);
            if (ot + 1u == epoch * ngroups) ab_add(topgen, 1u);
            else AB_SPIN(ab_ld(topgen) < epoch);
            ab_add(gen, 1u);
        } else {
            AB_SPIN(ab_ld(gen) < epoch);
        }
        __builtin_amdgcn_fence(__ATOMIC_ACQUIRE, "agent");
        asm volatile("s_waitcnt vmcnt(0)" ::: "memory");
    }
    __syncthreads();
}

#define GAS __attribute__((address_space(1)))
DI unsigned char* wsl(unsigned char* ws) { GAS unsigned char* g = (GAS unsigned char*)ws; asm volatile("" : "+s"(g)); return (unsigned char*)g; }
DI const float* argp(unsigned char* ws, int i) {
    GAS const unsigned long long* t = (GAS const unsigned long long*)(ws + WS_TAB);
    asm volatile("" : "+s"(t));
    GAS const float* p = (GAS const float*)t[i];
    return (const float*)p;
}

DI f32x2 gelu_pk(f32x2 v) {
    const f32x2 av = __builtin_elementwise_abs(v), d = av * 0.2316418882f + 1.0f;
    f32x2 t; t.x = __builtin_amdgcn_rcpf(d.x); t.y = __builtin_amdgcn_rcpf(d.y);
    f32x2 q = t * 0.5307027145f + (-0.7265760135f); q = q * t + 0.7107068705f; q = q * t + (-0.142248368f); q = q * t + 0.127414796f; q = q * t;
    const f32x2 s = (v * v) * (-0.72134752044f);
    f32x2 e; e.x = __builtin_amdgcn_exp2f(s.x); e.y = __builtin_amdgcn_exp2f(s.y);
    const f32x2 m = v * (q * e), r = v - m;
    f32x2 o; o.x = v.x < 0.f ? m.x : r.x; o.y = v.y < 0.f ? m.y : r.y; return o;
}

#define XB_TMO      128
#define XB_XCNT(j)  (256  + 64 * (j))
#define XB_XSUB(j)  (1280 + 64 * (j))
#define XB_XGEN(j)  (2304 + 64 * (j))
#define XB_TOP      3328
#define XB_TOPGEN   3392
#define XB_SPIN_CAP (1u << 22)
DI unsigned xb_xcc_id() { return (unsigned)__builtin_amdgcn_s_getreg((3 << 11) | 20) & 0xFu; }
#define XB_SPIN(cond, bar) do { unsigned _sp = 0; while (cond) { __builtin_amdgcn_s_sleep(1); \
    if ((++_sp & 255u) == 0u) { if (ab_ld(&(bar)[XB_TMO])) break; if (_sp > XB_SPIN_CAP) { atomicAdd(&(bar)[XB_TMO], 1u); break; } } } } while (0)
struct XcdBarrier { unsigned* bar; unsigned x; volatile LAS unsigned* st; };
DI XcdBarrier xcd_barrier_post(unsigned* bar, volatile LAS unsigned* st) {
    XcdBarrier b; b.bar = bar; b.x = xb_xcc_id(); b.st = st;
    if (threadIdx.x == 0) (void)ab_add(&bar[XB_XCNT(b.x)], 1u);
    return b;
}
DI void xcd_barrier_complete(unsigned* bar, unsigned x, unsigned& nloc, unsigned& nx) {
    const unsigned G = gridDim.x;
    unsigned sum, cnt, mine, sp = 0u;
    for (;;) {
        sum = 0u; cnt = 0u; mine = 0u;
#pragma unroll
        for (unsigned j = 0; j < 16; ++j) { const unsigned c = ab_ld(&bar[XB_XCNT(j)]); sum += c; cnt += (c > 0u) ? 1u : 0u; mine = (j == x) ? c : mine; }
        if (sum == G) break;
        __builtin_amdgcn_s_sleep(1);
        if ((++sp & 255u) == 0u) { if (ab_ld(&bar[XB_TMO])) break; if (sp > XB_SPIN_CAP) { atomicAdd(&bar[XB_TMO], 1u); break; } }
    }
    nloc = mine > 0u ? mine : 1u; nx = cnt > 0u ? cnt : 1u;
}
DI void xcd_barrier(const XcdBarrier& b) {
    asm volatile("s_waitcnt vmcnt(0)" ::: "memory");
    __syncthreads();
    if (threadIdx.x == 0) {
        unsigned* bar = b.bar;
        __builtin_amdgcn_s_waitcnt(0);
        unsigned nloc = b.st[0], nx = b.st[1];
        if (nloc == 0u) { xcd_barrier_complete(bar, b.x, nloc, nx); b.st[0] = nloc; b.st[1] = nx; }
        const unsigned old = ab_add(&bar[XB_XSUB(b.x)], 1u);
        const unsigned gen = old / nloc;
        if (old + 1u == (gen + 1u) * nloc) {
            __builtin_amdgcn_fence(__ATOMIC_RELEASE, "agent");
            asm volatile("s_waitcnt vmcnt(0)" ::: "memory");
            const unsigned og = ab_add(&bar[XB_TOP], 1u);
            const unsigned tg = og / nx;
            if (og + 1u == (tg + 1u) * nx) ab_add(&bar[XB_TOPGEN], 1u);
            else XB_SPIN(ab_ld(&bar[XB_TOPGEN]) == tg, bar);
            __builtin_amdgcn_fence(__ATOMIC_ACQUIRE, "agent");
            ab_add(&bar[XB_XGEN(b.x)], 1u);
            asm volatile("s_waitcnt vmcnt(0)" ::: "memory");
        } else {
            XB_SPIN(ab_ld(&bar[XB_XGEN(b.x)]) == gen, bar);
            __builtin_amdgcn_fence(__ATOMIC_ACQUIRE, "agent");
            asm volatile("s_waitcnt vmcnt(0)" ::: "memory");
        }
    }
    __syncthreads();
}

DI void item_signal(unsigned* ctr) {
    asm volatile("s_waitcnt vmcnt(0)" ::: "memory");
    __syncthreads();
    if (threadIdx.x == 0) { __builtin_amdgcn_fence(__ATOMIC_RELEASE, "agent"); asm volatile("s_waitcnt vmcnt(0)" ::: "memory"); ab_add(ctr, 1u); }
}
DI void item_wait(unsigned* ctr, unsigned target) {
    if (threadIdx.x == 0) { AB_SPIN(ab_ld(ctr) < target); __builtin_amdgcn_fence(__ATOMIC_ACQUIRE, "agent"); asm volatile("s_waitcnt vmcnt(0)" ::: "memory"); }
    __syncthreads();
}

DI void st16_wt(void* p, f32x4 v) { asm volatile("s_nop 1\n\tglobal_store_dwordx4 %0, %1, off sc1\n\ts_nop 1" :: "v"(p), "v"(v) : "memory"); }
DI void st16_wt(void* p, u32x4 v) { asm volatile("s_nop 1\n\tglobal_store_dwordx4 %0, %1, off sc1\n\ts_nop 1" :: "v"(p), "v"(v) : "memory"); }
DI void st8_wt(void* p, f32x2 v) { __hip_atomic_store((unsigned long long*)p, __builtin_bit_cast(unsigned long long, v), __ATOMIC_RELAXED, __HIP_MEMORY_SCOPE_AGENT); }
DI void item_signal_wt(unsigned* ctr) {
    asm volatile("s_waitcnt vmcnt(0)" ::: "memory");
    __syncthreads();
    if (threadIdx.x == 0) ab_add(ctr, 1u);
}

DI int rowbase(int pm) { return (pm >> 3) * LP + 128 + (pm & 7) * 256; }
namespace pg8 {
constexpr int BM = 256, BK = 64, HALF = 128, HTB = HALF * BK * 2, STAGE_BYTES = 8 * HTB, NXCD = 8, WGM = 8;
DI int lds_byte(int r, int c) { const int st = (r >> 4) * 2 + (c >> 5), rr = r & 15, cc = c & 31, ob = rr * 64 + cc * 2; return st * 1024 + (ob ^ (((ob >> 9) & 1) << 5)); }
DI void stage_rc(int b, int& R, int& C) { const int st = b / 1024, sb = b % 1024, swz = sb ^ (((sb >> 9) & 1) << 5); R = (st >> 1) * 16 + swz / 64; C = (st & 1) * 32 + (swz % 64) / 2; }
DI int perm32(int rho) { const int n = rho >> 4, i = rho & 15; return 8 * (i >> 2) + 4 * n + (i & 3); }
struct Unit { int pm, pn; };
struct Gemm { const bf16_t* A; const bf16_t* Bt; int M, N, K; };
struct StaticOrder {
    int nM, nN, nwg, G, c;
    DI void init(int M, int N, int G_, int c_) { nM = M / BM; nN = N / BM; nwg = nM * nN; G = G_; c = c_; }
    DI bool next(int i, Unit& u) const {
        const long L = (long)i * G + c; if (L >= nwg) return false;
        int wgid = (int)L; { const int q = nwg / NXCD, r = nwg % NXCD, xcd = wgid % NXCD, off = wgid / NXCD; wgid = (xcd < r ? xcd * (q + 1) : r * (q + 1) + (xcd - r) * q) + off; }
        const int nig = WGM * nN, gid = wgid / nig, fm = gid * WGM, gsz = (nM - fm) < WGM ? (nM - fm) : WGM;
        u.pm = fm + ((wgid % nig) % gsz); u.pn = (wgid % nig) / gsz; return true;
    }
    DI void a_ready(const Unit&) const {}
    DI void done(const Unit&) const {}
};

template <class Epi, class Sched>
DI void gemm_phase(LAS unsigned char* lds, const Gemm g, const Sched& S, const Epi& E) {
    const int tid = opaque_tid(), wid = __builtin_amdgcn_readfirstlane(tid >> 6), lane = tid & 63, wr = wid >> 2, wc = wid & 3, fr = lane & 15, fq = lane >> 4;
    const int K = g.K, nt = K / BK;
    unsigned voffA[2], voffB[2];
#pragma unroll
    for (int i = 0; i < 2; ++i) { int R, C; stage_rc(tid * 16 + i * 8192, R, C); const int Rb = Epi::PERM ? ((R & ~31) + perm32(R & 31)) : R;
        voffA[i] = (unsigned)(R * K + C) * 2u; voffB[i] = (unsigned)(Rb * K + C) * 2u; }
    const size_t kstep = (size_t)(BK * 2);
    const size_t hstep = (size_t)HALF * K * 2;
    const size_t tstep = 2 * hstep;
    const unsigned ldsw = (unsigned)wid * 1024u;
    const int aoff = lds_byte(wr * 64 + fr, fq * 8), boff = lds_byte(wc * 32 + fr, fq * 8);
#define PG8_SA(b, h) (((b) * 2 + (h)) * HTB)
#define PG8_SB(b, h) ((4 + (b) * 2 + (h)) * HTB)
#define PG8_STAGE(bufoff, gbase, voff) do { _Pragma("unroll") for (int _i = 0; _i < 2; ++_i) \
        __builtin_amdgcn_global_load_lds((const unsigned*)((const char*)(gbase) + (voff)[_i]), (LAS unsigned*)(lds + (bufoff) + ldsw + _i * 8192), 16, 0, 0); } while (0)
#define PG8_LDA(dst, b, h) do { _Pragma("unroll") for (int m = 0; m < 4; ++m) _Pragma("unroll") for (int k = 0; k < 2; ++k) dst[m][k] = *(const LAS bf16x8*)(lds + PG8_SA(b, h) + aoff + m * 2048 + k * 1024); } while (0)
#define PG8_LDB(dst, b, h) do { _Pragma("unroll") for (int n = 0; n < 2; ++n) _Pragma("unroll") for (int k = 0; k < 2; ++k) dst[n][k] = *(const LAS bf16x8*)(lds + PG8_SB(b, h) + boff + n * 2048 + k * 1024); } while (0)
#define PG8_MMA(ai, bj, At, Bt) do { __builtin_amdgcn_s_setprio(1); _Pragma("unroll") for (int m = 0; m < 4; ++m) _Pragma("unroll") for (int n = 0; n < 2; ++n) _Pragma("unroll") for (int k = 0; k < 2; ++k) \
        acc[ai][bj][m][n] = __builtin_amdgcn_mfma_f32_16x16x32_bf16(Bt[n][k], At[m][k], acc[ai][bj][m][n], 0, 0, 0); __builtin_amdgcn_s_setprio(0); } while (0)
#define PG8_WAIT_V(n) asm volatile("s_waitcnt vmcnt(" #n ")" ::: "memory")
#define PG8_WAIT_L(n) asm volatile("s_waitcnt lgkmcnt(" #n ")" ::: "memory")
#define PG8_BAR __builtin_amdgcn_s_barrier()
#define PG8_SCHED __builtin_amdgcn_sched_barrier(0)
    Unit cur, nxt; int ui = 0;
    if (!S.next(0, cur)) return;
    f32x4 acc[2][2][4][2];
#pragma unroll
    for (int a = 0; a < 2; ++a)
#pragma unroll
        for (int b = 0; b < 2; ++b)
#pragma unroll
            for (int m = 0; m < 4; ++m)
#pragma unroll
                for (int n = 0; n < 2; ++n) acc[a][b][m][n] = (f32x4){0.f, 0.f, 0.f, 0.f};
    bf16x8 At[4][2], B0[2][2], B1[2][2];
    const char* cA = (const char*)g.A + (size_t)rowbase(cur.pm) * K * 2; const char* cB = (const char*)g.Bt + (size_t)cur.pn * tstep;
    S.a_ready(cur);
    PG8_STAGE(PG8_SB(0, 0), cB, voffB); PG8_STAGE(PG8_SA(0, 0), cA, voffA); PG8_STAGE(PG8_SB(0, 1), cB + hstep, voffB); PG8_STAGE(PG8_SA(0, 1), cA + hstep, voffA);
    if (wr == 1) PG8_BAR;
    PG8_WAIT_V(4); PG8_BAR;
    PG8_STAGE(PG8_SB(1, 0), cB + kstep, voffB); PG8_STAGE(PG8_SA(1, 0), cA + kstep, voffA); PG8_STAGE(PG8_SB(1, 1), cB + hstep + kstep, voffB);
    PG8_WAIT_V(6); PG8_BAR;
    for (;;) {
        const bool has_next = S.next(ui + 1, nxt);
        const char* nA = has_next ? (const char*)g.A + (size_t)rowbase(nxt.pm) * K * 2 : cA; const char* nB = has_next ? (const char*)g.Bt + (size_t)nxt.pn * tstep : cB;
        constexpr int NH = Epi::MID_HOOK ? 2 : 1;
#pragma nounroll
        for (int hh = 0; hh < NH; ++hh) {
        if constexpr (Epi::MID_HOOK) { if (hh == 1) { const int l2 = opaque_tid() & 63; E.mid(acc, cur, wr, wc, l2 & 15, l2 >> 4); } }
        for (int t = hh * (nt / NH); t < (hh + 1) * (nt / NH); t += 2) {
            const bool last = (t == nt - 2);
            const char* a1 = cA + (size_t)(t + 1) * kstep;
            const char* a2 = last ? nA : cA + (size_t)(t + 2) * kstep; const char* b2 = last ? nB : cB + (size_t)(t + 2) * kstep;
            const char* a3 = a2 + kstep; const char* b3 = b2 + kstep;
            if (last && has_next) S.a_ready(nxt);
            PG8_LDB(B0, 0, 0); PG8_SCHED; PG8_LDA(At, 0, 0); PG8_STAGE(PG8_SA(1, 1), a1 + hstep, voffA);
            PG8_WAIT_L(8); PG8_BAR; PG8_WAIT_L(0); PG8_MMA(0, 0, At, B0); PG8_BAR; PG8_SCHED;
            PG8_LDB(B1, 0, 1); PG8_STAGE(PG8_SB(0, 0), b2, voffB);
            PG8_BAR; PG8_WAIT_L(0); PG8_MMA(0, 1, At, B1); PG8_BAR;
            PG8_LDA(At, 0, 1); PG8_STAGE(PG8_SA(0, 0), a2, voffA);
            PG8_BAR; PG8_WAIT_L(0); PG8_MMA(1, 0, At, B0); PG8_BAR; PG8_SCHED;
            PG8_STAGE(PG8_SB(0, 1), b2 + hstep, voffB);
            PG8_WAIT_V(6); PG8_BAR; PG8_MMA(1, 1, At, B1); PG8_BAR;
            PG8_LDB(B0, 1, 0); PG8_SCHED; PG8_LDA(At, 1, 0); PG8_STAGE(PG8_SA(0, 1), a2 + hstep, voffA);
            PG8_WAIT_L(8); PG8_BAR; PG8_WAIT_L(0); PG8_MMA(0, 0, At, B0); PG8_BAR; PG8_SCHED;
            PG8_LDB(B1, 1, 1); PG8_STAGE(PG8_SB(1, 0), b3, voffB);
            PG8_BAR; PG8_WAIT_L(0); PG8_MMA(0, 1, At, B1); PG8_BAR;
            PG8_LDA(At, 1, 1); PG8_STAGE(PG8_SA(1, 0), a3, voffA);
            PG8_BAR; PG8_WAIT_L(0); PG8_MMA(1, 0, At, B0); PG8_BAR; PG8_SCHED;
            PG8_STAGE(PG8_SB(1, 1), b3 + hstep, voffB);
            PG8_WAIT_V(6); PG8_BAR; PG8_MMA(1, 1, At, B1); PG8_BAR;
        }
        }
        if constexpr (!Epi::AFTER_DRAIN) { const int l2 = opaque_tid() & 63; E(acc, cur, wr, wc, l2 & 15, l2 >> 4); } S.done(cur);
        if (!has_next) break;
#pragma unroll
        for (int a = 0; a < 2; ++a)
#pragma unroll
            for (int b = 0; b < 2; ++b)
#pragma unroll
                for (int m = 0; m < 4; ++m)
#pragma unroll
                    for (int n = 0; n < 2; ++n) acc[a][b][m][n] = (f32x4){0.f, 0.f, 0.f, 0.f};
        cur = nxt; cA = nA; cB = nB; ++ui;
    }
    PG8_WAIT_V(0);
    if (wr == 0) PG8_BAR;
    PG8_BAR;
    if constexpr (Epi::AFTER_DRAIN) { const int l2 = opaque_tid() & 63; E.fused(acc, cur, wr, wc, l2 & 15, l2 >> 4); }
#undef PG8_SA
#undef PG8_SB
#undef PG8_STAGE
#undef PG8_LDA
#undef PG8_LDB
#undef PG8_MMA
#undef PG8_WAIT_V
#undef PG8_WAIT_L
#undef PG8_BAR
#undef PG8_SCHED
}
}
using pg8::Unit;

struct EpiIn {
    static constexpr bool PERM = true, AFTER_DRAIN = false, MID_HOOK = false;
    bf16_t* P; const float* TA; const float* TR;
    template <int KIND> DI void g8k(int row, int col, f32x4 v0, f32x4 v1) const {
        const int l = row % LP;
        if (KIND == 0 || KIND == 2) {
            const float* t = (KIND == 0) ? TA + ((size_t)l * 32 + ((col & 63) >> 1)) * 2 : TR + ((size_t)l * 64 + ((col & 127) >> 1)) * 2;
            const f32x4 t0 = *(const f32x4*)t, t1 = *(const f32x4*)(t + 4);
            f32x4 w0, w1;
            w0[0] = v0[0] * t0[0] - v0[1] * t0[1]; w0[1] = v0[1] * t0[0] + v0[0] * t0[1];
            w0[2] = v0[2] * t0[2] - v0[3] * t0[3]; w0[3] = v0[3] * t0[2] + v0[2] * t0[3];
            w1[0] = v1[0] * t1[0] - v1[1] * t1[1]; w1[1] = v1[1] * t1[0] + v1[0] * t1[1];
            w1[2] = v1[2] * t1[2] - v1[3] * t1[3]; w1[3] = v1[3] * t1[2] + v1[2] * t1[3];
            v0 = w0; v1 = w1;
            if (KIND == 2 && col >= C_RK) { const float sc = (l >= PADR) ? 0.08838834764831845f : 0.0f; v0 *= sc; v1 *= sc; }
        }
        if (KIND == 3) {
#pragma unroll
            for (int j = 0; j < 4; ++j) { v0[j] = v0[j] * sigmoidf_(v0[j]); v1[j] = v1[j] * sigmoidf_(v1[j]); }
        }
        if (KIND == 4) {
#pragma unroll
            for (int j = 0; j < 4; ++j) { v0[j] = sigmoidf_(v0[j]); v1[j] = sigmoidf_(v1[j]); }
        }
        u32x4 w; w.x = pk2(v0[0], v0[1]); w.y = pk2(v0[2], v0[3]); w.z = pk2(v1[0], v1[1]); w.w = pk2(v1[2], v1[3]);
        *(u32x4*)(P + (size_t)row * PLD + col) = w;
    }
    DI void g8(int row, int col, f32x4 v0, f32x4 v1) const {
        const int pn = col >> 8;
        if (pn < 16) g8k<0>(row, col, v0, v1);
        else if (pn < 24) g8k<1>(row, col, v0, v1);
        else if (pn < 32) g8k<2>(row, col, v0, v1);
        else if (pn < 40) g8k<1>(row, col, v0, v1);
        else if (pn < 48) g8k<3>(row, col, v0, v1);
        else g8k<4>(row, col, v0, v1);
    }
    template <int KIND> DI void g8rot(int row, int col, f32x4 v0, f32x4 v1, const f32x4 t0, const f32x4 t1) const {
        f32x4 w0, w1;
        w0[0] = v0[0] * t0[0] - v0[1] * t0[1]; w0[1] = v0[1] * t0[0] + v0[0] * t0[1];
        w0[2] = v0[2] * t0[2] - v0[3] * t0[3]; w0[3] = v0[3] * t0[2] + v0[2] * t0[3];
        w1[0] = v1[0] * t1[0] - v1[1] * t1[1]; w1[1] = v1[1] * t1[0] + v1[0] * t1[1];
        w1[2] = v1[2] * t1[2] - v1[3] * t1[3]; w1[3] = v1[3] * t1[2] + v1[2] * t1[3];
        if (KIND == 2 && col >= C_RK) { const float sc = ((row % LP) >= PADR) ? 0.08838834764831845f : 0.0f; w0 *= sc; w1 *= sc; }
        u32x4 w; w.x = pk2(w0[0], w0[1]); w.y = pk2(w0[2], w0[3]); w.z = pk2(w1[0], w1[1]); w.w = pk2(w1[2], w1[3]);
        *(u32x4*)(P + (size_t)row * PLD + col) = w;
    }
    template <int KIND> DI void run(const f32x4 (&acc)[2][2][4][2], const Unit& u, int wr, int wc, int fr, int fq) const {
        int row0 = rowbase(u.pm) + wr * 64 + fr, col0 = u.pn * 256 + wc * 32 + 8 * fq;
        asm volatile("" : "+v"(row0), "+v"(col0));
        if constexpr (KIND == 0 || KIND == 2) {
#pragma unroll
            for (int ai = 0; ai < 2; ++ai) {
                f32x4 ta[4], tb[4];
#pragma unroll
                for (int m = 0; m < 4; ++m) {
                    const int l = (row0 + ai * 128 + m * 16) % LP;
                    const float* t = (KIND == 0) ? TA + ((size_t)l * 32 + ((col0 & 63) >> 1)) * 2 : TR + ((size_t)l * 64 + ((col0 & 127) >> 1)) * 2;
                    ta[m] = *(const f32x4*)t; tb[m] = *(const f32x4*)(t + 4);
                }
                __builtin_amdgcn_sched_barrier(0);
#pragma unroll
                for (int m = 0; m < 4; ++m)
#pragma unroll
                    for (int bj = 0; bj < 2; ++bj) { g8rot<KIND>(row0 + ai * 128 + m * 16, col0 + bj * 128, acc[ai][bj][m][0], acc[ai][bj][m][1], ta[m], tb[m]); __builtin_amdgcn_sched_barrier(0); }
            }
        } else {
#pragma unroll
            for (int ai = 0; ai < 2; ++ai)
#pragma unroll
                for (int m = 0; m < 4; ++m)
#pragma unroll
                    for (int bj = 0; bj < 2; ++bj) { g8k<KIND>(row0 + ai * 128 + m * 16, col0 + bj * 128, acc[ai][bj][m][0], acc[ai][bj][m][1]); __builtin_amdgcn_sched_barrier(0); }
        }
    }
    DI void operator()(const f32x4 (&acc)[2][2][4][2], const Unit& u, int wr, int wc, int fr, int fq) const {
        const int pn = u.pn;
        if (pn < 16) run<0>(acc, u, wr, wc, fr, fq);
        else if (pn < 24) run<1>(acc, u, wr, wc, fr, fq);
        else if (pn < 32) run<2>(acc, u, wr, wc, fr, fq);
        else if (pn < 40) run<1>(acc, u, wr, wc, fr, fq);
        else if (pn < 48) run<3>(acc, u, wr, wc, fr, fq);
        else run<4>(acc, u, wr, wc, fr, fq);
    }
};
template <int WHICH> struct EpiBr {
    static constexpr bool PERM = true, AFTER_DRAIN = false, MID_HOOK = false;
    const bf16_t* P; float* TMP; bf16_t* MG;
    DI void g8(int row, int col, f32x4 a0, f32x4 a1) const {
        const u32x4 gw = *(const u32x4*)(P + (size_t)row * PLD + (WHICH == 0 ? C_GA : C_GB) + col);
        f32x4 g0, g1;
        g0[0] = bf2f(gw.x & 0xffffu); g0[1] = bf2f(gw.x >> 16); g0[2] = bf2f(gw.y & 0xffffu); g0[3] = bf2f(gw.y >> 16);
        g1[0] = bf2f(gw.z & 0xffffu); g1[1] = bf2f(gw.z >> 16); g1[2] = bf2f(gw.w & 0xffffu); g1[3] = bf2f(gw.w >> 16);
        f32x4 v0 = a0 * g0, v1 = a1 * g1;
        float* tp = TMP + (size_t)row * D + col;
        if (WHICH == 0) { *(f32x4*)tp = v0; *(f32x4*)(tp + 4) = v1; }
        else {
            v0 += *(const f32x4*)tp; v1 += *(const f32x4*)(tp + 4);
            u32x4 w; w.x = pk2(v0[0], v0[1]); w.y = pk2(v0[2], v0[3]); w.z = pk2(v1[0], v1[1]); w.w = pk2(v1[2], v1[3]);
            *(u32x4*)(MG + (size_t)row * D + col) = w;
        }
    }
    DI void operator()(const f32x4 (&acc)[2][2][4][2], const Unit& u, int wr, int wc, int fr, int fq) const {
        const int row0 = rowbase(u.pm) + wr * 64 + fr, col0 = u.pn * 256 + wc * 32 + 8 * fq;
#pragma unroll
        for (int ai = 0; ai < 2; ++ai)
#pragma unroll
            for (int m = 0; m < 4; ++m)
#pragma unroll
                for (int bj = 0; bj < 2; ++bj) g8(row0 + ai * 128 + m * 16, col0 + bj * 128, acc[ai][bj][m][0], acc[ai][bj][m][1]);
    }
};
struct EpiRes {
    static constexpr bool PERM = false, AFTER_DRAIN = false, MID_HOOK = false;
    const float* HF; float* PRE;
    DI void g4(int row, int col, f32x4 a) const {
        const size_t o = (size_t)row * D + col;
        *(f32x4*)(PRE + o) = *(const f32x4*)(HF + o) * ALPHA + a;
    }
    DI void g8(int row, int col, f32x4 a0, f32x4 a1) const { g4(row, col, a0); g4(row, col + 4, a1); }
    DI void operator()(const f32x4 (&acc)[2][2][4][2], const Unit& u, int wr, int wc, int fr, int fq) const {
        const int row0 = rowbase(u.pm) + wr * 64 + fr, col0 = u.pn * 256 + wc * 32 + 4 * fq;
#pragma unroll
        for (int ai = 0; ai < 2; ++ai)
#pragma unroll
            for (int m = 0; m < 4; ++m)
#pragma unroll
                for (int bj = 0; bj < 2; ++bj)
#pragma unroll
                    for (int n = 0; n < 2; ++n) g4(row0 + ai * 128 + m * 16, col0 + bj * 128 + n * 16, acc[ai][bj][m][n]);
    }
};
struct EpiUp {
    static constexpr bool PERM = true, AFTER_DRAIN = false, MID_HOOK = false;
    bf16_t* U;
    DI void g8(int row, int col, f32x4 v0, f32x4 v1) const {
        u32x4 w; w.x = pk2(v0[0], v0[1]); w.y = pk2(v0[2], v0[3]); w.z = pk2(v1[0], v1[1]); w.w = pk2(v1[2], v1[3]);
        *(u32x4*)(U + (size_t)row * DFF2 + col) = w;
    }
    DI void operator()(const f32x4 (&acc)[2][2][4][2], const Unit& u, int wr, int wc, int fr, int fq) const {
        int row0 = rowbase(u.pm) + wr * 64 + fr, col0 = u.pn * 256 + wc * 32 + 8 * fq;
        asm volatile("" : "+v"(row0), "+v"(col0));
#pragma unroll
        for (int ai = 0; ai < 2; ++ai)
#pragma unroll
            for (int m = 0; m < 4; ++m)
#pragma unroll
                for (int bj = 0; bj < 2; ++bj) g8(row0 + ai * 128 + m * 16, col0 + bj * 128, acc[ai][bj][m][0], acc[ai][bj][m][1]);
    }
};

template <class Epi> DI void meta_gemm(const bf16_t* __restrict__ A, const bf16_t* __restrict__ Bt, int N, int K, const Epi& E, unsigned char* smem) {
    const int tid = opaque_tid(), wid = __builtin_amdgcn_readfirstlane(tid >> 6), lane = tid & 63, i16 = lane & 15, kq = lane >> 4;
    float* R = (float*)smem;
    const int nsteps = K / 32, s0 = (wid * nsteps) >> 3, s1 = ((wid + 1) * nsteps) >> 3;
    const bf16_t* ap = A + (size_t)(PADR + i16) * K + 8 * kq;
    for (int task = blockIdx.x; task < N / 32; task += gridDim.x) {
        const int cbase = task * 32;
        const bf16_t* w0 = Bt + (size_t)(cbase + 8 * (i16 >> 2) + (i16 & 3)) * K + 8 * kq;
        const bf16_t* w1 = w0 + (size_t)4 * K;
        f32x4 c0 = {0.f, 0.f, 0.f, 0.f}, c1 = {0.f, 0.f, 0.f, 0.f};
#pragma unroll 4
        for (int st = s0; st < s1; ++st) {
            const bf16x8 af = *(const bf16x8*)(ap + st * 32);
            const bf16x8 b0 = *(const bf16x8*)(w0 + st * 32), b1 = *(const bf16x8*)(w1 + st * 32);
            c0 = __builtin_amdgcn_mfma_f32_16x16x32_bf16(b0, af, c0, 0, 0, 0);
            c1 = __builtin_amdgcn_mfma_f32_16x16x32_bf16(b1, af, c1, 0, 0, 0);
        }
        *(f32x4*)(R + ((wid * 2 + 0) * 64 + lane) * 4) = c0;
        *(f32x4*)(R + ((wid * 2 + 1) * 64 + lane) * 4) = c1;
        __syncthreads();
        if (wid == 0) {
            f32x4 v0 = {0.f, 0.f, 0.f, 0.f}, v1 = {0.f, 0.f, 0.f, 0.f};
#pragma unroll
            for (int w = 0; w < 8; ++w) { v0 += *(const f32x4*)(R + ((w * 2 + 0) * 64 + lane) * 4); v1 += *(const f32x4*)(R + ((w * 2 + 1) * 64 + lane) * 4); }
            for (int b = 0; b < NB; ++b) E.g8(b * LP + PADR + i16, cbase + 8 * kq, v0, v1);
        }
        __syncthreads();
    }
}


struct EpiMerge {
    static constexpr bool PERM = true, AFTER_DRAIN = false, MID_HOOK = true;
    const bf16_t* P; bf16_t* MG;
    DI static void unpack8(const u32x4 gw, f32x4& g0, f32x4& g1) {
        g0[0] = bf2f(gw.x & 0xffffu); g0[1] = bf2f(gw.x >> 16); g0[2] = bf2f(gw.y & 0xffffu); g0[3] = bf2f(gw.y >> 16);
        g1[0] = bf2f(gw.z & 0xffffu); g1[1] = bf2f(gw.z >> 16); g1[2] = bf2f(gw.w & 0xffffu); g1[3] = bf2f(gw.w >> 16);
    }
    DI void mid(f32x4 (&acc)[2][2][4][2], const Unit& u, int wr, int wc, int fr, int fq) const {
        int row0 = rowbase(u.pm) + wr * 64 + fr, col0 = u.pn * 256 + wc * 32 + 8 * fq;
        asm volatile("" : "+v"(row0), "+v"(col0));
#pragma unroll
        for (int ai = 0; ai < 2; ++ai)
#pragma unroll
            for (int m = 0; m < 4; ++m)
#pragma unroll
                for (int bj = 0; bj < 2; ++bj) {
                    const bf16_t* gp = P + (size_t)(row0 + ai * 128 + m * 16) * PLD + col0 + bj * 128;
                    f32x4 a0, a1, b0, b1;
                    unpack8(*(const u32x4*)(gp + C_GA), a0, a1); unpack8(*(const u32x4*)(gp + C_GB), b0, b1);
#pragma unroll
                    for (int j = 0; j < 4; ++j) { acc[ai][bj][m][0][j] *= a0[j] * __builtin_amdgcn_rcpf(b0[j]); acc[ai][bj][m][1][j] *= a1[j] * __builtin_amdgcn_rcpf(b1[j]); }
                    asm volatile("" ::: "memory");
                }
    }
    DI void operator()(const f32x4 (&acc)[2][2][4][2], const Unit& u, int wr, int wc, int fr, int fq) const {
        int row0 = rowbase(u.pm) + wr * 64 + fr, col0 = u.pn * 256 + wc * 32 + 8 * fq;
        asm volatile("" : "+v"(row0), "+v"(col0));
#pragma unroll
        for (int ai = 0; ai < 2; ++ai)
#pragma unroll
            for (int m = 0; m < 4; ++m)
#pragma unroll
                for (int bj = 0; bj < 2; ++bj) {
                    const int row = row0 + ai * 128 + m * 16, col = col0 + bj * 128;
                    f32x4 b0, b1;
                    unpack8(*(const u32x4*)(P + (size_t)row * PLD + C_GB + col), b0, b1);
                    const f32x4 v0 = acc[ai][bj][m][0] * b0, v1 = acc[ai][bj][m][1] * b1;
                    u32x4 w; w.x = pk2(v0[0], v0[1]); w.y = pk2(v0[2], v0[3]); w.z = pk2(v1[0], v1[1]); w.w = pk2(v1[2], v1[3]);
                    *(u32x4*)(MG + (size_t)row * D + col) = w;
                }
    }
};
DI void meta_gemm_merge(const bf16_t* __restrict__ A, const bf16_t* __restrict__ Bt, const EpiMerge& E, unsigned char* smem) {
    const int tid = opaque_tid(), wid = __builtin_amdgcn_readfirstlane(tid >> 6), lane = tid & 63, i16 = lane & 15, kq = lane >> 4;
    float* R = (float*)smem;
    constexpr int K2 = 2 * D, nsteps = K2 / 32;
    const int s0 = (wid * nsteps) >> 3, s1 = ((wid + 1) * nsteps) >> 3;
    const bf16_t* ap = A + (size_t)(PADR + i16) * K2 + 8 * kq;
    const int task = blockIdx.x;
    if (task >= D / 32) return;
    const int cbase = task * 32;
    const bf16_t* w0 = Bt + (size_t)(cbase + 8 * (i16 >> 2) + (i16 & 3)) * K2 + 8 * kq;
    const bf16_t* w1 = w0 + (size_t)4 * K2;
    f32x4 c0 = {0.f, 0.f, 0.f, 0.f}, c1 = {0.f, 0.f, 0.f, 0.f};
#pragma unroll 4
    for (int st = s0; st < s1; ++st) {
        const bf16x8 af = *(const bf16x8*)(ap + st * 32);
        const bf16x8 b0 = *(const bf16x8*)(w0 + st * 32), b1 = *(const bf16x8*)(w1 + st * 32);
        c0 = __builtin_amdgcn_mfma_f32_16x16x32_bf16(b0, af, c0, 0, 0, 0);
        c1 = __builtin_amdgcn_mfma_f32_16x16x32_bf16(b1, af, c1, 0, 0, 0);
    }
    *(f32x4*)(R + ((wid * 2 + 0) * 64 + lane) * 4) = c0;
    *(f32x4*)(R + ((wid * 2 + 1) * 64 + lane) * 4) = c1;
    __syncthreads();
    if (wid == 0) {
        f32x4 a0 = {0.f, 0.f, 0.f, 0.f}, a1 = a0, b0 = a0, b1 = a0;
#pragma unroll
        for (int w = 0; w < 4; ++w) { a0 += *(const f32x4*)(R + ((w * 2 + 0) * 64 + lane) * 4); a1 += *(const f32x4*)(R + ((w * 2 + 1) * 64 + lane) * 4); }
#pragma unroll
        for (int w = 4; w < 8; ++w) { b0 += *(const f32x4*)(R + ((w * 2 + 0) * 64 + lane) * 4); b1 += *(const f32x4*)(R + ((w * 2 + 1) * 64 + lane) * 4); }
        const int col = cbase + 8 * kq;
        const bf16_t* gp = E.P + (size_t)(PADR + i16) * PLD + col;
        f32x4 ga0, ga1, gb0, gb1;
        EpiMerge::unpack8(*(const u32x4*)(gp + C_GA), ga0, ga1); EpiMerge::unpack8(*(const u32x4*)(gp + C_GB), gb0, gb1);
        const f32x4 v0 = a0 * ga0 + b0 * gb0, v1 = a1 * ga1 + b1 * gb1;
        u32x4 w; w.x = pk2(v0[0], v0[1]); w.y = pk2(v0[2], v0[3]); w.z = pk2(v1[0], v1[1]); w.w = pk2(v1[2], v1[3]);
        for (int bb = 0; bb < NB; ++bb) *(u32x4*)(E.MG + (size_t)(bb * LP + PADR + i16) * D + col) = w;
    }
    __syncthreads();
}

struct EpiLN {
    static constexpr bool PERM = false, AFTER_DRAIN = true, MID_HOOK = false;
    float* HF; bf16_t* HB; float* OUT; const float* g; const float* b; float* STATS; unsigned* cnt; unsigned char* smem;
    DI void fused(f32x4 (&acc)[2][2][4][2], const Unit& u, int wr, int wc, int fr, int fq) const {
        const int tid = opaque_tid();
        const int rb = rowbase(u.pm), rl0 = wr * 64 + fr, col0 = u.pn * 256 + wc * 32 + 4 * fq;
        float* part = (float*)smem;
        float* mr = part + 2048;
#pragma unroll
        for (int ai = 0; ai < 2; ++ai)
#pragma unroll
            for (int m = 0; m < 4; ++m) {
                const int rl = rl0 + ai * 128 + m * 16;
                const size_t ro = (size_t)(rb + rl) * D + col0;
                float sm = 0.f, sq = 0.f;
#pragma unroll
                for (int bj = 0; bj < 2; ++bj)
#pragma unroll
                    for (int n = 0; n < 2; ++n) {
                        const f32x4 x = *(const f32x4*)(HF + ro + bj * 128 + n * 16) * ALPHA + acc[ai][bj][m][n];
                        acc[ai][bj][m][n] = x;
                        sm += (x[0] + x[1]) + (x[2] + x[3]); sq += (x[0] * x[0] + x[1] * x[1]) + (x[2] * x[2] + x[3] * x[3]);
                    }
                sm += shx(sm, 16); sq += shx(sq, 16);
                sm += shx(sm, 32); sq += shx(sq, 32);
                if (fq == 0) { part[(wc * 256 + rl) * 2] = sm; part[(wc * 256 + rl) * 2 + 1] = sq; }
            }
        __syncthreads();
        if (tid < 256) {
            float S = 0.f, Q = 0.f;
#pragma unroll
            for (int w = 0; w < 4; ++w) { S += part[(w * 256 + tid) * 2]; Q += part[(w * 256 + tid) * 2 + 1]; }
            f32x2 v = {S, Q};
            st8_wt(STATS + ((size_t)(u.pm * 8 + u.pn) * 256 + tid) * 2, v);
        }
        asm volatile("s_waitcnt vmcnt(0)" ::: "memory");
        __syncthreads();
        if (tid == 0) {
            ab_add(cnt + u.pm, 1u);
            AB_SPIN(ab_ld(cnt + u.pm) < 8u);
            __builtin_amdgcn_fence(__ATOMIC_ACQUIRE, "agent"); asm volatile("s_waitcnt vmcnt(0)" ::: "memory");
        }
        __syncthreads();
        if (tid < 256) {
            float S = 0.f, Q = 0.f;
#pragma unroll
            for (int p = 0; p < 8; ++p) { const f32x2 v = *(const f32x2*)(STATS + ((size_t)(u.pm * 8 + p) * 256 + tid) * 2); S += v[0]; Q += v[1]; }
            const float mean = S * (1.0f / D), var = fmaxf(Q * (1.0f / D) - mean * mean, 0.f);
            mr[tid * 2] = mean; mr[tid * 2 + 1] = rsqrtf(var + EPS);
        }
        __syncthreads();
        f32x4 gv[2][2], bv[2][2];
#pragma unroll
        for (int bj = 0; bj < 2; ++bj)
#pragma unroll
            for (int n = 0; n < 2; ++n) { gv[bj][n] = *(const f32x4*)(g + col0 + bj * 128 + n * 16); bv[bj][n] = *(const f32x4*)(b + col0 + bj * 128 + n * 16); }
#pragma unroll
        for (int ai = 0; ai < 2; ++ai)
#pragma unroll
            for (int m = 0; m < 4; ++m) {
                const int rl = rl0 + ai * 128 + m * 16, row = rb + rl;
                const float mean = mr[rl * 2], rstd = mr[rl * 2 + 1];
#pragma unroll
                for (int bj = 0; bj < 2; ++bj)
#pragma unroll
                    for (int n = 0; n < 2; ++n) {
                        const int col = col0 + bj * 128 + n * 16;
                        const f32x4 y = (acc[ai][bj][m][n] - mean) * rstd * gv[bj][n] + bv[bj][n];
                        if (OUT) { const int bb = row / LP, l = row % LP; *(f32x4*)(OUT + ((size_t)bb * SEQ + (l - 128)) * D + col) = y; }
                        else {
                            *(f32x4*)(HF + (size_t)row * D + col) = y;
                            u32x2 w; w.x = pk2(y[0], y[1]); w.y = pk2(y[2], y[3]);
                            *(u32x2*)(HB + (size_t)row * D + col) = w;
                        }
                    }
            }
        __syncthreads();
    }
};
DI void meta_gemm_ln(const bf16_t* __restrict__ A, const bf16_t* __restrict__ Bt, int K, const EpiLN& E, unsigned char* smem) {
    const int tid = opaque_tid(), wid = __builtin_amdgcn_readfirstlane(tid >> 6), lane = tid & 63, i16 = lane & 15, kq = lane >> 4;
    float* R = (float*)smem;
    const int nsteps = K / 32, s0 = (wid * nsteps) >> 3, s1 = ((wid + 1) * nsteps) >> 3;
    const bf16_t* ap = A + (size_t)(PADR + i16) * K + 8 * kq;
    const int task = blockIdx.x;
    if (task >= D / 32) return;
    const int cbase = task * 32;
    const bf16_t* w0 = Bt + (size_t)(cbase + 8 * (i16 >> 2) + (i16 & 3)) * K + 8 * kq;
    const bf16_t* w1 = w0 + (size_t)4 * K;
    f32x4 c0 = {0.f, 0.f, 0.f, 0.f}, c1 = {0.f, 0.f, 0.f, 0.f};
#pragma unroll 4
    for (int st = s0; st < s1; ++st) {
        const bf16x8 af = *(const bf16x8*)(ap + st * 32);
        const bf16x8 b0 = *(const bf16x8*)(w0 + st * 32), b1 = *(const bf16x8*)(w1 + st * 32);
        c0 = __builtin_amdgcn_mfma_f32_16x16x32_bf16(b0, af, c0, 0, 0, 0);
        c1 = __builtin_amdgcn_mfma_f32_16x16x32_bf16(b1, af, c1, 0, 0, 0);
    }
    *(f32x4*)(R + ((wid * 2 + 0) * 64 + lane) * 4) = c0;
    *(f32x4*)(R + ((wid * 2 + 1) * 64 + lane) * 4) = c1;
    __syncthreads();
    if (wid == 0) {
        f32x4 v0 = {0.f, 0.f, 0.f, 0.f}, v1 = {0.f, 0.f, 0.f, 0.f};
#pragma unroll
        for (int w = 0; w < 8; ++w) { v0 += *(const f32x4*)(R + ((w * 2 + 0) * 64 + lane) * 4); v1 += *(const f32x4*)(R + ((w * 2 + 1) * 64 + lane) * 4); }
        const int col = cbase + 8 * kq;
        const size_t o0 = (size_t)(PADR + i16) * D + col;
        v0 += *(const f32x4*)(E.HF + o0) * ALPHA; v1 += *(const f32x4*)(E.HF + o0 + 4) * ALPHA;
        float sm = (v0[0] + v0[1]) + (v0[2] + v0[3]) + (v1[0] + v1[1]) + (v1[2] + v1[3]);
        float sq = (v0[0] * v0[0] + v0[1] * v0[1]) + (v0[2] * v0[2] + v0[3] * v0[3]) + (v1[0] * v1[0] + v1[1] * v1[1]) + (v1[2] * v1[2] + v1[3] * v1[3]);
        sm += shx(sm, 16); sq += shx(sq, 16);
        sm += shx(sm, 32); sq += shx(sq, 32);
        float* SM = E.STATS + (size_t)32 * 8 * 256 * 2;
        if (kq == 0) { f32x2 v = {sm, sq}; st8_wt(SM + (task * 16 + i16) * 2, v); }
        asm volatile("s_waitcnt vmcnt(0)" ::: "memory");
        if (lane == 0) {
            ab_add(E.cnt + 32, 1u);
            AB_SPIN(ab_ld(E.cnt + 32) < 64u);
            __builtin_amdgcn_fence(__ATOMIC_ACQUIRE, "agent"); asm volatile("s_waitcnt vmcnt(0)" ::: "memory");
        }
        __builtin_amdgcn_wave_barrier();
        float S = 0.f, Q = 0.f;
        for (int t = 0; t < 64; ++t) { const f32x2 v = *(const f32x2*)(SM + (t * 16 + i16) * 2); S += v[0]; Q += v[1]; }
        const float mean = S * (1.0f / D), var = fmaxf(Q * (1.0f / D) - mean * mean, 0.f), rstd = rsqrtf(var + EPS);
        const f32x4 g0 = *(const f32x4*)(E.g + col), g1 = *(const f32x4*)(E.g + col + 4), b0 = *(const f32x4*)(E.b + col), b1 = *(const f32x4*)(E.b + col + 4);
        const f32x4 y0 = (v0 - mean) * rstd * g0 + b0, y1 = (v1 - mean) * rstd * g1 + b1;
        u32x4 w; w.x = pk2(y0[0], y0[1]); w.y = pk2(y0[2], y0[3]); w.z = pk2(y1[0], y1[1]); w.w = pk2(y1[2], y1[3]);
        for (int bb = 0; bb < NB; ++bb) {
            const size_t o = (size_t)(bb * LP + PADR + i16) * D + col;
            *(f32x4*)(E.HF + o) = y0; *(f32x4*)(E.HF + o + 4) = y1;
            *(u32x4*)(E.HB + o) = w;
        }
    }
    __syncthreads();
}

DI int win_dst_row(int sc) {
    if (sc < 4096) { const int g = sc & ~63, j = sc & 63; return g + ((j & 31) << 1) + (j >> 5); }
    if (sc >= C_RQ && sc < C_RV) { const int g = sc & ~127, j = sc & 127; return g + ((j & 63) << 1) + (j >> 6); }
    return sc;
}
template <bool PERMW> DI void transpose_convert(const float* __restrict__ src, bf16_t* __restrict__ dst, int K, int N) {
    const int tid = opaque_tid(), wid = tid >> 6, lane = tid & 63;
    const int ntn = N / 64, ntk = (K + 255) / 256, ntile = ntn * ntk;
    for (int t = blockIdx.x; t < ntile; t += gridDim.x) {
        const int tn = t / ntk, tk = t % ntk;
        const int s4 = tn * 64 + (lane & 15) * 4, kb = tk * 256 + (wid * 4 + (lane >> 4)) * 8;
        if (kb < K) {
            f32x4 v[8];
#pragma unroll
            for (int j = 0; j < 8; ++j) v[j] = *(const f32x4*)(src + (size_t)(kb + j) * N + s4);
#pragma unroll
            for (int e = 0; e < 4; ++e) {
                const int n = PERMW ? win_dst_row(s4 + e) : (s4 + e);
                u32x4 w; w.x = pk2(v[0][e], v[1][e]); w.y = pk2(v[2][e], v[3][e]); w.z = pk2(v[4][e], v[5][e]); w.w = pk2(v[6][e], v[7][e]);
                *(u32x4*)(dst + (size_t)n * K + kb) = w;
            }
        }
    }
}

struct CvtTile { const float* src; bf16_t* dst; int K, N, t, ldd; bool perm; };
DI void cvt_load(const CvtTile& c, f32x4 (&v)[8], int& s4, int& kb, int wid, int lane) {
    const int ntk = (c.K + 255) / 256;
    const int tn = c.t / ntk, tk = c.t % ntk;
    s4 = tn * 64 + (lane & 15) * 4; kb = tk * 256 + (wid * 4 + (lane >> 4)) * 8;
    if (kb < c.K) {
#pragma unroll
        for (int j = 0; j < 8; ++j) v[j] = __builtin_nontemporal_load((const f32x4*)(c.src + (size_t)(kb + j) * c.N + s4));
    }
}
DI void cvt_store(const CvtTile& c, const f32x4 (&v)[8], int s4, int kb) {
    if (kb < c.K) {
#pragma unroll
        for (int e = 0; e < 4; ++e) {
            const int n = c.perm ? win_dst_row(s4 + e) : (s4 + e);
            u32x4 w; w.x = pk2(v[0][e], v[1][e]); w.y = pk2(v[2][e], v[3][e]); w.z = pk2(v[4][e], v[5][e]); w.w = pk2(v[6][e], v[7][e]);
            *(u32x4*)(c.dst + (size_t)n * c.ldd + kb) = w;
        }
    }
}
constexpr int CT_SQ = 32 * 8, CT_UP = 172 * 8, CT_DN = 32 * 22, CT_IN = 256 * 8;
constexpr int CT_L0 = 3 * CT_SQ + CT_UP + CT_DN, CT_TOTAL = 2 * CT_L0 + CT_IN, CT_PER_ITEM = 16, CT_ITEMS = (CT_TOTAL + CT_PER_ITEM - 1) / CT_PER_ITEM;
DI CvtTile deferred_tile(unsigned char* ws, int t) {
    CvtTile c; c.perm = false; c.ldd = 0;
    int l = 0;
    if (t >= CT_L0) { t -= CT_L0; l = 1;
        if (t < CT_IN) { c.src = argp(ws, 4) + (size_t)D * WIN; c.dst = (bf16_t*)(ws + WS_WIN + SZ_WIN); c.K = D; c.N = WIN; c.t = t; c.ldd = D; c.perm = true; return c; }
        t -= CT_IN; }
    if (t < CT_SQ) { c.src = argp(ws, 11) + (size_t)l * D * D; c.dst = (bf16_t*)(ws + WS_WA + l * 2 * SZ_SQ); c.K = D; c.N = D; c.t = t; c.ldd = 2 * D; return c; }
    t -= CT_SQ;
    if (t < CT_SQ) { c.src = argp(ws, 12) + (size_t)l * D * D; c.dst = (bf16_t*)(ws + WS_WA + l * 2 * SZ_SQ) + D; c.K = D; c.N = D; c.t = t; c.ldd = 2 * D; return c; }
    t -= CT_SQ;
    if (t < CT_SQ) { c.src = argp(ws, 13) + (size_t)l * D * D; c.dst = (bf16_t*)(ws + WS_WO + l * SZ_SQ); c.K = D; c.N = D; c.t = t; c.ldd = D; return c; }
    t -= CT_SQ;
    if (t < CT_UP) { c.src = argp(ws, 16) + (size_t)l * D * DFF2; c.dst = (bf16_t*)(ws + WS_WUP + l * SZ_WUP); c.K = D; c.N = DFF2; c.t = t; c.ldd = D; return c; }
    t -= CT_UP;
    c.src = argp(ws, 19) + (size_t)l * DFF * D; c.dst = (bf16_t*)(ws + WS_WDN + l * SZ_WDN); c.K = DFF; c.N = D; c.t = t; c.ldd = DFF; return c;
}
DI void convert_deferred_item(unsigned char* ws, int item) {
    const int tid = opaque_tid(), wid = tid >> 6, lane = tid & 63;
    const int t0 = item * CT_PER_ITEM;
#pragma nounroll
    for (int t = t0; t < t0 + CT_PER_ITEM; t += 4) {
        if (t >= CT_TOTAL) break;
        CvtTile c[4]; f32x4 v[4][8]; int s4[4], kb[4];
#pragma unroll
        for (int q = 0; q < 4; ++q) { c[q] = deferred_tile(ws, (t + q < CT_TOTAL) ? t + q : t); }
#pragma unroll
        for (int q = 0; q < 4; ++q) if (t + q < CT_TOTAL) cvt_load(c[q], v[q], s4[q], kb[q], wid, lane);
#pragma unroll
        for (int q = 0; q < 4; ++q) if (t + q < CT_TOTAL) cvt_store(c[q], v[q], s4[q], kb[q]);
    }
}

DI void ln_row(f32x4 (&x)[8], const float* __restrict__ g, const float* __restrict__ b, int lane) {
    float s = 0.f;
#pragma unroll
    for (int j = 0; j < 8; ++j) s += x[j][0] + x[j][1] + x[j][2] + x[j][3];
    const float mu = wave_sum(s) * (1.0f / D);
    float q = 0.f;
#pragma unroll
    for (int j = 0; j < 8; ++j) {
#pragma unroll
        for (int e = 0; e < 4; ++e) { const float d = x[j][e] - mu; q += d * d; }
    }
    const float rstd = rsqrtf(wave_sum(q) * (1.0f / D) + EPS);
#pragma unroll
    for (int j = 0; j < 8; ++j) { const int c = (j * 64 + lane) * 4; const f32x4 gv = *(const f32x4*)(g + c), bv = *(const f32x4*)(b + c);
#pragma unroll
        for (int e = 0; e < 4; ++e) x[j][e] = (x[j][e] - mu) * rstd * gv[e] + bv[e]; }
}
DI void store_h(const f32x4 (&x)[8], float* HF, bf16_t* HB, int row, int lane) {
#pragma unroll
    for (int j = 0; j < 8; ++j) { const int c = (j * 64 + lane) * 4;
        *(f32x4*)(HF + (size_t)row * D + c) = x[j];
        u32x2 w; w.x = pk2(x[j][0], x[j][1]); w.y = pk2(x[j][2], x[j][3]);
        *(u32x2*)(HB + (size_t)row * D + c) = w; }
}

template <int VT> DI void attn_pv2(f32x16& oa, f32x16& ob, unsigned vb, const bf16x8 (&pf)[2][2]) {
    const s16x4 al00 = tr_read<(0) * 320 + VT * 64>(vb), ah00 = tr_read<(8) * 320 + VT * 64>(vb);
    const s16x4 al01 = tr_read<(16) * 320 + VT * 64>(vb), ah01 = tr_read<(24) * 320 + VT * 64>(vb);
    const s16x4 al10 = tr_read<(32) * 320 + VT * 64>(vb), ah10 = tr_read<(40) * 320 + VT * 64>(vb);
    const s16x4 al11 = tr_read<(48) * 320 + VT * 64>(vb), ah11 = tr_read<(56) * 320 + VT * 64>(vb);
    const s16x4 bl00 = tr_read<(0) * 320 + VT * 64 + 64>(vb), bh00 = tr_read<(8) * 320 + VT * 64 + 64>(vb);
    const s16x4 bl01 = tr_read<(16) * 320 + VT * 64 + 64>(vb), bh01 = tr_read<(24) * 320 + VT * 64 + 64>(vb);
    const s16x4 bl10 = tr_read<(32) * 320 + VT * 64 + 64>(vb), bh10 = tr_read<(40) * 320 + VT * 64 + 64>(vb);
    const s16x4 bl11 = tr_read<(48) * 320 + VT * 64 + 64>(vb), bh11 = tr_read<(56) * 320 + VT * 64 + 64>(vb);
    LGKM0();
    oa = MFMA32(PK8(al00, ah00), pf[0][0], oa); ob = MFMA32(PK8(bl00, bh00), pf[0][0], ob);
    oa = MFMA32(PK8(al01, ah01), pf[0][1], oa); ob = MFMA32(PK8(bl01, bh01), pf[0][1], ob);
    oa = MFMA32(PK8(al10, ah10), pf[1][0], oa); ob = MFMA32(PK8(bl10, bh10), pf[1][0], ob);
    oa = MFMA32(PK8(al11, ah11), pf[1][1], oa); ob = MFMA32(PK8(bl11, bh11), pf[1][1], ob);
}
constexpr int AK_STR = 272, AV_STR = 320, AK_BUF = 64 * AK_STR, AV_BUF = 64 * AV_STR, AV_BASE = 2 * AK_BUF;
struct AttnCtx { int r, h, mp, qb, qrow; unsigned lds0, vlane; unsigned char* smem; };
DI void attn_S(f32x16 (&st)[2], const bf16x8 (&bq)[4], const AttnCtx& c, int kc) {
    bf16x8 kf[2][4];
    const unsigned char* kbase = c.smem + kc * AK_BUF + c.r * AK_STR + (c.mp * 64 + c.h * 8) * 2;
#pragma unroll
    for (int ksub = 0; ksub < 2; ++ksub)
#pragma unroll
        for (int ks = 0; ks < 4; ++ks) kf[ksub][ks] = *(const bf16x8*)(kbase + ksub * 32 * AK_STR + ks * 32);
#pragma unroll
    for (int i = 0; i < 16; ++i) { st[0][i] = 0.f; st[1][i] = 0.f; }
    LGKM0();
#pragma unroll
    for (int ks = 0; ks < 4; ++ks) { st[0] = MFMA32(kf[0][ks], bq[ks], st[0]); st[1] = MFMA32(kf[1][ks], bq[ks], st[1]); }
}
DI void attn_softmax(f32x16 (&st)[2], bf16x8 (&pf)[2][2], f32x16 (&ot)[4], float& mrun, float& lrun, const AttnCtx& c, int kt) {
    const float CS = 0.125f * 1.4426950408889634f;
    const bool need_mask = (kt < 2) || (kt >= 2 * c.qb);
#pragma unroll
    for (int ksub = 0; ksub < 2; ++ksub)
#pragma unroll
        for (int i = 0; i < 16; ++i) st[ksub][i] *= CS;
    if (need_mask) {
#pragma unroll
        for (int ksub = 0; ksub < 2; ++ksub)
#pragma unroll
            for (int i = 0; i < 16; ++i) {
                const int key = kt * 64 + ksub * 32 + crow(i, c.h);
                const bool ok = (key <= c.qrow) && (key >= PADR || key == c.qrow);
                st[ksub][i] = ok ? st[ksub][i] : -1e30f;
            }
    }
    float mx = -INFINITY;
#pragma unroll
    for (int ksub = 0; ksub < 2; ++ksub)
#pragma unroll
        for (int i = 0; i < 16; ++i) mx = fmaxf(mx, st[ksub][i]);
    mx = fmaxf(mx, shx(mx, 32));
    const bool raise = (mx - mrun) > 8.0f;
    const float mnew = raise ? mx : mrun;
    const float alpha = raise ? fexp2(mrun - mnew) : 1.0f;
    mrun = mnew;
    float ls = 0.f;
#pragma unroll
    for (int ksub = 0; ksub < 2; ++ksub)
#pragma unroll
        for (int i = 0; i < 16; ++i) { const float p = fexp2(st[ksub][i] - mnew); st[ksub][i] = p; ls += p; }
    lrun = lrun * alpha + ls;
    if (__builtin_amdgcn_ballot_w64(alpha != 1.0f) != 0ull) {
#pragma unroll
        for (int v = 0; v < 4; ++v)
#pragma unroll
            for (int i = 0; i < 16; ++i) ot[v][i] *= alpha;
    }
#pragma unroll
    for (int ksub = 0; ksub < 2; ++ksub)
#pragma unroll
        for (int s = 0; s < 2; ++s)
            pf[ksub][s] = pack8(st[ksub][8 * s], st[ksub][8 * s + 1], st[ksub][8 * s + 2], st[ksub][8 * s + 3], st[ksub][8 * s + 4], st[ksub][8 * s + 5], st[ksub][8 * s + 6], st[ksub][8 * s + 7]);
}
DI void attn_PV(f32x16 (&ot)[4], const bf16x8 (&pf)[2][2], const AttnCtx& c, int vc) {
    const unsigned vb = c.lds0 + AV_BASE + vc * AV_BUF + c.vlane;
    attn_pv2<0>(ot[0], ot[1], vb, pf); attn_pv2<2>(ot[2], ot[3], vb, pf);
}
DI void attn_item(const bf16_t* __restrict__ P, bf16_t* __restrict__ OA, const float* __restrict__ subg, float lam, float one_m_li,
                  int b, int hd, int qb, unsigned char* smem) {
    const int tid = opaque_tid(), wid = __builtin_amdgcn_readfirstlane(tid >> 6), lane = tid & 63, r = lane & 31, h = lane >> 5;
    const int mp = wid >> 2, qs = wid & 3;
    const bf16_t* Pb = P + (size_t)b * LP * PLD;
    const int qrow = qb * 128 + qs * 32 + r;
    bf16x8 bq[4];
#pragma unroll
    for (int ks = 0; ks < 4; ++ks) bq[ks] = *(const bf16x8*)(Pb + (size_t)qrow * PLD + C_AQ + hd * 128 + mp * 64 + ks * 16 + h * 8);
    f32x16 ot[4];
#pragma unroll
    for (int v = 0; v < 4; ++v)
#pragma unroll
        for (int i = 0; i < 16; ++i) ot[v][i] = 0.f;
    float mrun = -INFINITY, lrun = 0.f;
    const int kt0 = (qb >= 1) ? 1 : 0, kt1 = 2 * (qb + 1);
    u32x4 pk[2], pv[2];
    const int srow = tid >> 4, sc16 = tid & 15;
    const bf16_t* gsrc = Pb + (size_t)srow * PLD + hd * 128 + sc16 * 8;
#define A_GLOAD(kt) do { _Pragma("unroll") for (int _i = 0; _i < 2; ++_i) { const bf16_t* _s = gsrc + (size_t)((kt) * 64 + 32 * _i) * PLD; \
        pk[_i] = *(const u32x4*)(_s + C_AK); pv[_i] = *(const u32x4*)(_s + C_AV); } } while (0)
#define A_LSTORE(kbuf, vbuf, ktile) do { _Pragma("unroll") for (int _i = 0; _i < 2; ++_i) { \
        if ((ktile) < 2 && (ktile) * 64 + 32 * _i + srow < PADR) { pk[_i] = (u32x4){0u, 0u, 0u, 0u}; pv[_i] = (u32x4){0u, 0u, 0u, 0u}; }     \
        *(u32x4*)(smem + (kbuf) * AK_BUF + (srow + 32 * _i) * AK_STR + sc16 * 16) = pk[_i]; \
        *(u32x4*)(smem + AV_BASE + (vbuf) * AV_BUF + (srow + 32 * _i) * AV_STR + sc16 * 16) = pv[_i]; } } while (0)
    A_GLOAD(kt0); A_LSTORE(0, 0, kt0);
    __syncthreads();
    AttnCtx c; c.r = r; c.h = h; c.mp = mp; c.qb = qb; c.qrow = qrow; c.smem = smem; c.lds0 = (unsigned)(size_t)smem;
    c.vlane = (unsigned)((4 * h + ((lane >> 2) & 3)) * AV_STR + (16 * ((lane >> 4) & 1) + 4 * (lane & 3)) * 2);
    f32x16 st[2];
    bf16x8 pf[2][2];
    int kc = 0, vc = 0, vp = 2;
    if (mp == 0) {
        for (int kt = kt0; kt < kt1; ++kt) {
            const int vn = (vc == 2) ? 0 : vc + 1;
            if (kt + 1 < kt1) A_GLOAD(kt + 1);
            attn_S(st, bq, c, kc); attn_softmax(st, pf, ot, mrun, lrun, c, kt); attn_PV(ot, pf, c, vc);
            if (kt + 1 < kt1) A_LSTORE(kc ^ 1, vn, kt + 1);
            __syncthreads();
            kc ^= 1; vp = vc; vc = vn;
        }
    } else {
        for (int kt = kt0; kt < kt1; ++kt) {
            const int vn = (vc == 2) ? 0 : vc + 1;
            if (kt + 1 < kt1) A_GLOAD(kt + 1);
            if (kt > kt0) attn_PV(ot, pf, c, vp);
            attn_S(st, bq, c, kc); attn_softmax(st, pf, ot, mrun, lrun, c, kt);
            if (kt + 1 < kt1) A_LSTORE(kc ^ 1, vn, kt + 1);
            __syncthreads();
            kc ^= 1; vp = vc; vc = vn;
        }
        attn_PV(ot, pf, c, vp);
    }
#undef A_GLOAD
#undef A_LSTORE
    const float ltot = lrun + shx(lrun, 32);
    const float inv = 1.0f / ltot;
    float* X = (float*)smem;
    __syncthreads();
    if (mp == 1) {
#pragma unroll
        for (int v = 0; v < 4; ++v)
#pragma unroll
            for (int i = 0; i < 16; ++i) X[(qs * 64 + v * 16 + i) * 64 + lane] = ot[v][i] * inv;
    }
    __syncthreads();
    if (mp == 0) {
        float ss = 0.f;
#pragma unroll
        for (int v = 0; v < 4; ++v)
#pragma unroll
            for (int i = 0; i < 16; ++i) { const float o = ot[v][i] * inv - lam * X[(qs * 64 + v * 16 + i) * 64 + lane]; ot[v][i] = o; ss += o * o; }
        ss += shx(ss, 32);
        const float rs = rsqrtf(ss * (1.0f / 128.0f) + EPS) * one_m_li;
        bf16_t* orow = OA + (size_t)(b * LP + qrow) * (2 * D) + hd * 128;
#pragma unroll
        for (int v = 0; v < 4; ++v)
#pragma unroll
            for (int g4 = 0; g4 < 4; ++g4) {
                const int vc2 = 32 * v + 8 * g4 + 4 * h;
                const f32x4 gv = *(const f32x4*)(subg + vc2);
                u32x2 w; w.x = pk2(ot[v][4 * g4] * rs * gv[0], ot[v][4 * g4 + 1] * rs * gv[1]); w.y = pk2(ot[v][4 * g4 + 2] * rs * gv[2], ot[v][4 * g4 + 3] * rs * gv[3]);
                *(u32x2*)(orow + vc2) = w;
            }
    }
    __syncthreads();
}

constexpr int RV_STR = 576, RV_BYTES = 128 * RV_STR, RKA_STR = 320, RKC_STR = 272;
DI void ret_stage_v(const bf16_t* __restrict__ Pb, int c, int h8, unsigned char* smem) {
    const int tid = opaque_tid();
#pragma unroll
    for (int i = 0; i < 8; ++i) { const int p = tid + 512 * i, row = p >> 5, c16 = p & 31;
        u32x4 w = {0u, 0u, 0u, 0u};
        if (c > 0 || row >= PADR) w = *(const u32x4*)(Pb + (size_t)(c * 128 + row) * PLD + C_RV + h8 * 256 + c16 * 8);
        *(u32x4*)(smem + row * RV_STR + c16 * 16) = w; }
}
template <int S> DI void reta_step(f32x16 (&acc)[4], unsigned va0, unsigned ka0) {
    const unsigned va = va0 + (unsigned)(16 * S * RV_STR), ka = ka0 + (unsigned)(16 * S * RKA_STR);
    const s16x4 al = tr_read<0>(va), ah = tr_read<4 * RV_STR>(va);
    const s16x4 b0l = tr_read<0>(ka), b0h = tr_read<4 * RKA_STR + 0>(ka);
    const s16x4 b1l = tr_read<64>(ka), b1h = tr_read<4 * RKA_STR + 64>(ka);
    const s16x4 b2l = tr_read<128>(ka), b2h = tr_read<4 * RKA_STR + 128>(ka);
    const s16x4 b3l = tr_read<192>(ka), b3h = tr_read<4 * RKA_STR + 192>(ka);
    LGKM0();
    const bf16x8 a = PK8(al, ah);
    acc[0] = MFMA32(a, PK8(b0l, b0h), acc[0]);
    acc[1] = MFMA32(a, PK8(b1l, b1h), acc[1]);
    acc[2] = MFMA32(a, PK8(b2l, b2h), acc[2]);
    acc[3] = MFMA32(a, PK8(b3l, b3h), acc[3]);
}
DI void reta_item(const bf16_t* __restrict__ P, float* __restrict__ KVT, int b, int h8, int c, unsigned char* smem) {
    const int tid = opaque_tid(), wid = __builtin_amdgcn_readfirstlane(tid >> 6), lane = tid & 63, r = lane & 31, h = lane >> 5;
    const bf16_t* Pb = P + (size_t)b * LP * PLD;
    const float lg2 = __log2f(1.0f - fexp2(-5.0f - (float)h8));
    ret_stage_v(Pb, c, h8, smem);
#pragma unroll
    for (int i = 0; i < 4; ++i) { const int p = tid + 512 * i, row = p >> 4, c16 = p & 15;
        u32x4 w = {0u, 0u, 0u, 0u};
        if (c > 0 || row >= PADR) w = *(const u32x4*)(Pb + (size_t)(c * 128 + row) * PLD + C_RK + h8 * 128 + c16 * 8);
        const float d = fexp2(lg2 * (float)(127 - row));
        u32x4 o;
        o.x = pk2(bf2f(w.x & 0xffffu) * d, bf2f(w.x >> 16) * d); o.y = pk2(bf2f(w.y & 0xffffu) * d, bf2f(w.y >> 16) * d);
        o.z = pk2(bf2f(w.z & 0xffffu) * d, bf2f(w.z >> 16) * d); o.w = pk2(bf2f(w.w & 0xffffu) * d, bf2f(w.w >> 16) * d);
        *(u32x4*)(smem + RV_BYTES + row * RKA_STR + c16 * 16) = o; }
    __syncthreads();
    f32x16 acc[4];
#pragma unroll
    for (int t = 0; t < 4; ++t)
#pragma unroll
        for (int i = 0; i < 16; ++i) acc[t][i] = 0.f;
    const unsigned lds0 = (unsigned)(size_t)smem;
    const int qq = (lane >> 2) & 3, pp = lane & 3, blk = (lane >> 4) & 1;
    const unsigned va = lds0 + (unsigned)((8 * h + qq) * RV_STR + (32 * wid + 16 * blk + 4 * pp) * 2);
    const unsigned ka = lds0 + RV_BYTES + (unsigned)((8 * h + qq) * RKA_STR + (16 * blk + 4 * pp) * 2);
    reta_step<0>(acc, va, ka); reta_step<1>(acc, va, ka); reta_step<2>(acc, va, ka); reta_step<3>(acc, va, ka);
    reta_step<4>(acc, va, ka); reta_step<5>(acc, va, ka); reta_step<6>(acc, va, ka); reta_step<7>(acc, va, ka);
    __syncthreads();
    float* Lw = (float*)smem + wid * 4096;
#pragma unroll
    for (int t = 0; t < 4; ++t)
#pragma unroll
        for (int i = 0; i < 16; ++i) Lw[crow(i, h) * 128 + 32 * t + r] = acc[t][i];
    asm volatile("s_waitcnt lgkmcnt(0)" ::: "memory");
    float* dst = KVT + ((size_t)((b * 8 + h8) * 16 + c)) * 32768 + (size_t)(32 * wid) * 128;
    const int orow = lane >> 5, ocol = (lane & 31) * 4;
#pragma unroll
    for (int j = 0; j < 16; ++j) st16_wt(dst + (2 * j + orow) * 128 + ocol, *(const f32x4*)(Lw + (2 * j + orow) * 128 + ocol));
    __syncthreads();
}
template <int VT> DI void retc_pv(f32x16& o, unsigned vb, const bf16x8 (&pf)[2]) {
    const s16x4 l0 = tr_read<(0) * RV_STR + VT * 64>(vb), h0 = tr_read<(8) * RV_STR + VT * 64>(vb);
    const s16x4 l1 = tr_read<(16) * RV_STR + VT * 64>(vb), h1 = tr_read<(24) * RV_STR + VT * 64>(vb);
    LGKM0();
    o = MFMA32(PK8(l0, h0), pf[0], o);
    o = MFMA32(PK8(l1, h1), pf[1], o);
}
DI void retc_item(const bf16_t* __restrict__ P, const bf16_t* __restrict__ PREVT, bf16_t* __restrict__ OR_, const float* __restrict__ gng,
                  int b, int h8, int c, unsigned char* smem) {
    const int tid = opaque_tid(), wid = __builtin_amdgcn_readfirstlane(tid >> 6), lane = tid & 63, r = lane & 31, h = lane >> 5;
    const int nb = wid & 3, dh = wid >> 2;
    const bf16_t* Pb = P + (size_t)b * LP * PLD;
    const float lg2 = __log2f(1.0f - fexp2(-5.0f - (float)h8));
    u32x4 rv[8], rk[4];
#pragma unroll
    for (int i = 0; i < 8; ++i) { const int p = tid + 512 * i, row = p >> 5, c16 = p & 31;
        rv[i] = (u32x4){0u, 0u, 0u, 0u};
        if (c > 0 || row >= PADR) rv[i] = *(const u32x4*)(Pb + (size_t)(c * 128 + row) * PLD + C_RV + h8 * 256 + c16 * 8); }
#pragma unroll
    for (int i = 0; i < 4; ++i) { const int p = tid + 512 * i, row = p >> 4, c16 = p & 15;
        rk[i] = (u32x4){0u, 0u, 0u, 0u};
        if (c > 0 || row >= PADR) rk[i] = *(const u32x4*)(Pb + (size_t)(c * 128 + row) * PLD + C_RK + h8 * 128 + c16 * 8); }
    const int nloc = 32 * nb + r;
    const int grow = b * LP + c * 128 + nloc;
    bf16x8 bq[8];
#pragma unroll
    for (int ks = 0; ks < 8; ++ks) bq[ks] = *(const bf16x8*)(P + (size_t)grow * PLD + C_RQ + h8 * 128 + ks * 16 + h * 8);
    f32x16 acc[4];
    const bf16_t* pv = PREVT + ((size_t)((b * 8 + h8) * 17 + c)) * 32768 + (size_t)(128 * dh + r) * 128 + h * 8;
    bf16x8 pa[2][8];
#pragma unroll
    for (int ks = 0; ks < 8; ++ks) pa[0][ks] = *(const bf16x8*)(pv + ks * 16);
#pragma unroll
    for (int v = 0; v < 4; ++v) {
        if (v + 1 < 4) {
#pragma unroll
            for (int ks = 0; ks < 8; ++ks) pa[(v + 1) & 1][ks] = *(const bf16x8*)(pv + (size_t)(32 * (v + 1)) * 128 + ks * 16);
        }
#pragma unroll
        for (int i = 0; i < 16; ++i) acc[v][i] = 0.f;
#pragma unroll
        for (int ks = 0; ks < 8; ++ks) acc[v] = MFMA32(pa[v & 1][ks], bq[ks], acc[v]);
    }
#pragma unroll
    for (int i = 0; i < 8; ++i) { const int p = tid + 512 * i, row = p >> 5, c16 = p & 31; *(u32x4*)(smem + row * RV_STR + c16 * 16) = rv[i]; }
#pragma unroll
    for (int i = 0; i < 4; ++i) { const int p = tid + 512 * i, row = p >> 4, c16 = p & 15; *(u32x4*)(smem + RV_BYTES + row * RKC_STR + c16 * 16) = rk[i]; }
    __syncthreads();
    const float dq = fexp2(lg2 * (float)(nloc + 1));
#pragma unroll
    for (int v = 0; v < 4; ++v)
#pragma unroll
        for (int i = 0; i < 16; ++i) acc[v][i] *= dq;
    const unsigned lds0 = (unsigned)(size_t)smem;
    const int qq = (lane >> 2) & 3, pp = lane & 3, blk = (lane >> 4) & 1;
    for (int mt = 0; mt <= nb; ++mt) {
        f32x16 st;
#pragma unroll
        for (int i = 0; i < 16; ++i) st[i] = 0.f;
#pragma unroll
        for (int ks = 0; ks < 8; ++ks) {
            const bf16x8 a = *(const bf16x8*)(smem + RV_BYTES + (32 * mt + r) * RKC_STR + (ks * 16 + h * 8) * 2);
            st = MFMA32(a, bq[ks], st);
        }
#pragma unroll
        for (int i = 0; i < 16; ++i) { const int dd = nloc - (32 * mt + crow(i, h)); st[i] = (dd >= 0) ? st[i] * fexp2(lg2 * (float)dd) : 0.f; }
        bf16x8 pf[2];
        pf[0] = pack8(st[0], st[1], st[2], st[3], st[4], st[5], st[6], st[7]);
        pf[1] = pack8(st[8], st[9], st[10], st[11], st[12], st[13], st[14], st[15]);
        const unsigned vb = lds0 + (unsigned)((32 * mt + 4 * h + qq) * RV_STR + (128 * dh + 16 * blk + 4 * pp) * 2);
        retc_pv<0>(acc[0], vb, pf); retc_pv<1>(acc[1], vb, pf); retc_pv<2>(acc[2], vb, pf); retc_pv<3>(acc[3], vb, pf);
    }
    float s1 = 0.f, s2 = 0.f;
#pragma unroll
    for (int v = 0; v < 4; ++v)
#pragma unroll
        for (int i = 0; i < 16; ++i) { s1 += acc[v][i]; s2 += acc[v][i] * acc[v][i]; }
    s1 += shx(s1, 32); s2 += shx(s2, 32);
    float* ST = (float*)(smem + RV_BYTES + 128 * RKC_STR);
    if (h == 0) { ST[(dh * 128 + nloc) * 2] = s1; ST[(dh * 128 + nloc) * 2 + 1] = s2; }
    __syncthreads();
    const float t1 = ST[nloc * 2] + ST[(128 + nloc) * 2], t2 = ST[nloc * 2 + 1] + ST[(128 + nloc) * 2 + 1];
    const float mu = t1 * (1.0f / 256.0f);
    const float var = fmaxf(t2 * (1.0f / 256.0f) - mu * mu, 0.f);
    const float rstd = rsqrtf(var + EPS);
#pragma unroll
    for (int v = 0; v < 4; ++v)
#pragma unroll
        for (int g4 = 0; g4 < 4; ++g4) {
            const int col = h8 * 256 + 128 * dh + 32 * v + 8 * g4 + 4 * h;
            const f32x4 gv = *(const f32x4*)(gng + col);
            const u32x2 sw = *(const u32x2*)(P + (size_t)grow * PLD + C_RG + col);
            const float y0 = (acc[v][4 * g4] - mu) * rstd * gv[0] * bf2f(sw.x & 0xffffu);
            const float y1 = (acc[v][4 * g4 + 1] - mu) * rstd * gv[1] * bf2f(sw.x >> 16);
            const float y2 = (acc[v][4 * g4 + 2] - mu) * rstd * gv[2] * bf2f(sw.y & 0xffffu);
            const float y3 = (acc[v][4 * g4 + 3] - mu) * rstd * gv[3] * bf2f(sw.y >> 16);
            u32x2 w; w.x = pk2(y0, y1); w.y = pk2(y2, y3);
            *(u32x2*)(OR_ + (size_t)grow * (2 * D) + col) = w;
        }
    __syncthreads();
}

__global__ void __launch_bounds__(512, 2) fwd_megakernel(Params prm) {
    extern __shared__ __attribute__((aligned(16))) unsigned char smem[];
    cg::grid_group grid = cg::this_grid();
    unsigned epoch = 0;
    unsigned char* ws = prm.ws;
#define WSP(T, OFF) ((T*)(wsl(ws) + (OFF)))
#define BAR WSP(unsigned, WS_BAR)
#define GSYNC() xcd_barrier(xb)
    const int tid = threadIdx.x, wid = tid >> 6, lane = tid & 63;
#define LAM WSP(float, WS_LAM)
#define TA WSP(float, WS_TA)
#define TR WSP(float, WS_TR)
#define HF WSP(float, WS_HF)
#define HB WSP(bf16_t, WS_HB)
#define P WSP(bf16_t, WS_P)
#define U WSP(bf16_t, WS_P)
#define OA WSP(bf16_t, WS_OA)
#define OR_ (WSP(bf16_t, WS_OA) + D)
#define MG WSP(bf16_t, WS_MG)
#define PREVT WSP(bf16_t, WS_MG)
#define ACT WSP(bf16_t, WS_ACT)
#define KVT WSP(float, WS_ACT)
    LAS unsigned char* lds = (LAS unsigned char*)smem;
    volatile LAS unsigned* xst = (volatile LAS unsigned*)(lds + LDS_MISC + 16);
    if (threadIdx.x == 0) { xst[0] = 0u; xst[1] = 0u; }
    __syncthreads();
    const XcdBarrier xb = xcd_barrier_post((unsigned*)(prm.ws + WS_XB), xst);
    const int gw = blockIdx.x * 8 + wid, nw = gridDim.x * 8;

    {
        const int ct = opaque_tid(), cwv = ct >> 6, cln = ct & 63;
#pragma nounroll
        for (int k0 = 0; k0 < 8; k0 += 4) {
            CvtTile c[4]; f32x4 v[4][8]; int s4[4], kb[4];
#pragma unroll
            for (int q = 0; q < 4; ++q) { c[q].src = prm.in[4]; c[q].dst = (bf16_t*)(ws + WS_WIN); c[q].K = D; c[q].N = WIN; c[q].ldd = D; c[q].perm = true; c[q].t = (int)(blockIdx.x + gridDim.x * (k0 + q)); }
#pragma unroll
            for (int q = 0; q < 4; ++q) if (c[q].t < CT_IN) cvt_load(c[q], v[q], s4[q], kb[q], cwv, cln);
#pragma unroll
            for (int q = 0; q < 4; ++q) if (c[q].t < CT_IN) cvt_store(c[q], v[q], s4[q], kb[q]);
        }
    }
    for (int i = blockIdx.x * 512 + tid; i < LP * 96; i += gridDim.x * 512) {
        const int l = i / 96, j = i % 96; const float pos = (float)(l - PADR);
        float f; float* dst;
        if (j < 32) { f = 1.0f / powf(10000.0f, (float)(2 * j) / 64.0f); dst = TA + ((size_t)l * 32 + j) * 2; }
        else { const int jj = j - 32; f = 1.0f / powf(10000.0f, (float)jj / 63.0f); dst = TR + ((size_t)l * 64 + jj) * 2; }
        const float ang = pos * f;
        dst[0] = (float)cos((double)ang); dst[1] = (float)sin((double)ang);
    }
    if (tid < 23) ((const float**)(ws + WS_TAB))[tid] = (tid < 22) ? prm.in[tid] : (const float*)prm.out;
    if (blockIdx.x == 0 && tid < 2) {
        const int l = tid; float s1 = 0.f, s2 = 0.f;
        for (int i = 0; i < 64; ++i) { s1 += prm.in[5][l * 64 + i] * prm.in[6][l * 64 + i]; s2 += prm.in[7][l * 64 + i] * prm.in[8][l * 64 + i]; }
        const float li = 0.8f - 0.6f * expf(-0.3f * (float)l);
        LAM[l] = expf(s1) - expf(s2) + li;
    }
    for (int row = gw; row < MROWS; row += nw) {
        const int b = row / LP, l = row % LP;
        if (l < PADR) continue;
        f32x4 x[8];
        {
            const float* src = (l < 128) ? prm.in[1] + (size_t)(l - PADR) * D : prm.in[0] + ((size_t)b * SEQ + (l - 128)) * D;
#pragma unroll
            for (int j = 0; j < 8; ++j) x[j] = *(const f32x4*)(src + (j * 64 + lane) * 4);
        }
        ln_row(x, prm.in[2], prm.in[3], lane);
        store_h(x, HF, HB, row, lane);
    }
    grid.sync();

#pragma nounroll
    for (int layer = 0; layer < 2; ++layer) {
        const float lam_init = 0.8f - 0.6f * expf(-0.3f * (float)layer);
        for (int rep = 0; rep < REP_INPROJ; ++rep)
        {
            pg8::Gemm g{HB, (const bf16_t*)(ws + WS_WIN + layer * SZ_WIN), MROWS, WIN, D};
            pg8::StaticOrder S; S.init(NB * SEQ, WIN, gridDim.x, blockIdx.x);
            EpiIn E{P, TA, TR};
            pg8::gemm_phase(lds, g, S, E);
            meta_gemm(g.A, g.Bt, WIN, D, E, smem);
        }
        GSYNC();
        for (int rep = 0; rep < REP_ATTN; ++rep)
        {
            const float lam = LAM[layer];
            volatile int* sidx = (volatile int*)(smem + LDS_MISC);
            const int qt = opaque_tid();
            const int grp = blockIdx.x & 7;
            unsigned* qbase = (unsigned*)(ws + WS_QCTR);
            unsigned* qctr = qbase + 16 * (layer * 8 + grp) + 256 * rep;
            unsigned* pa_done = qbase + 512 + layer * 32;
            unsigned* sc_done = qbase + 576 + layer * 32;
            for (;;) {
                if (qt == 0) *sidx = (int)atomicAdd(qctr, 1u);
                __syncthreads();
                const int idx = __builtin_amdgcn_readfirstlane(*sidx);
                __syncthreads();
                const int NC = (layer == 0) ? ((CT_ITEMS - grp + 7) >> 3) : 0;
                if (idx >= 300 + NC) break;
                if (idx < 64) {
                    const int bh = grp + 8 * (idx >> 4), c = idx & 15;
                    reta_item(P, KVT, bh >> 3, bh & 7, c, smem);
                    item_signal_wt(pa_done + bh);
                } else if (idx < 96) {
                    const int j = idx - 64, bh = grp + 8 * (j >> 3), part = j & 7, h8 = bh & 7;
                    item_wait(pa_done + bh, 16u);
                    const int off = part * 4096 + qt * 8;
                    const float cd = fexp2(128.0f * __log2f(1.0f - fexp2(-5.0f - (float)h8)));
                    float sst[8]; float zz = 0.f; asm volatile("" : "+v"(zz));
#pragma unroll
                    for (int e = 0; e < 8; ++e) sst[e] = zz;
#pragma unroll 4
                    for (int c = 0; c < 17; ++c) {
                        u32x4 w; w.x = pk2(sst[0], sst[1]); w.y = pk2(sst[2], sst[3]); w.z = pk2(sst[4], sst[5]); w.w = pk2(sst[6], sst[7]);
                        st16_wt(PREVT + ((size_t)(bh * 17 + c)) * 32768 + off, w);
                        if (c < 16) {
                            const float* kp = KVT + ((size_t)(bh * 16 + c)) * 32768 + off;
                            const f32x4 k0 = *(const f32x4*)kp, k1 = *(const f32x4*)(kp + 4);
#pragma unroll
                            for (int e = 0; e < 4; ++e) { sst[e] = cd * sst[e] + k0[e]; sst[4 + e] = cd * sst[4 + e] + k1[e]; }
                        }
                    }
                    item_signal_wt(sc_done + bh);
                } else if (idx < 232 + NC) {
                    const int p = idx - 96;
                    int ai = -1, ci = -1;
                    if (p < 3 * NC) { if (p % 3 == 2) ci = p / 3; else ai = p - p / 3; } else ai = p - NC;
                    if (ai >= 136) { ci = NC - 1 - (ai - 136); ai = -1; }
                    if (ci >= 0) {
                        const int item = grp + 8 * ci;
                        convert_deferred_item(ws, item);
                    } else {
                        const int bh = grp + 8 * (ai / 17), qb = 16 - (ai % 17);
                        attn_item(P, OA, argp(ws, 9) + layer * 128, lam, 1.0f - lam_init, bh >> 4, bh & 15, qb, smem);
                    }
                } else {
                    const int j = idx - 232 - NC; const int bh = grp + 8 * (j / 17), c = j % 17;
                    item_wait(sc_done + bh, 8u);
                    retc_item(P, PREVT, OR_, argp(ws, 10) + layer * D, bh >> 3, bh & 7, c, smem);
                }
            }
        }
        GSYNC();
        {
            pg8::StaticOrder S; S.init(NB * SEQ, D, gridDim.x, blockIdx.x);
            pg8::Gemm g{OA, (const bf16_t*)(ws + WS_WA + layer * 2 * SZ_SQ), MROWS, D, 2 * D};
            EpiMerge E{P, MG};
            pg8::gemm_phase(lds, g, S, E);
            meta_gemm_merge(g.A, g.Bt, E, smem);
        }
        GSYNC();
        {
            pg8::StaticOrder S; S.init(NB * SEQ, D, gridDim.x, blockIdx.x);
            pg8::Gemm g{MG, (const bf16_t*)(ws + WS_WO + layer * SZ_SQ), MROWS, D, D};
            EpiLN E{HF, HB, nullptr, argp(ws, 14) + layer * D, argp(ws, 15) + layer * D, (float*)(ws + WS_STATS), (unsigned*)(ws + WS_LNCNT) + (layer * 2 + 0) * 64, smem};
            pg8::gemm_phase(lds, g, S, E);
            meta_gemm_ln(g.A, g.Bt, D, E, smem);
        }
        GSYNC();
        {
            pg8::StaticOrder S; S.init(NB * SEQ, DFF2, gridDim.x, blockIdx.x);
            pg8::Gemm g{HB, (const bf16_t*)(ws + WS_WUP + layer * SZ_WUP), MROWS, DFF2, D};
            EpiUp E{U};
            pg8::gemm_phase(lds, g, S, E);
            meta_gemm(g.A, g.Bt, DFF2, D, E, smem);
        }
        GSYNC();
        for (int rep = 0; rep < REP_MISC; ++rep)
        {
            const float* cw = argp(ws, 17) + (size_t)layer * 3 * DFF2; const float* cb = argp(ws, 18) + (size_t)layer * DFF2;
            const int ctid = opaque_tid();
            for (int idx = blockIdx.x * 512 + ctid; idx < NB * 129 * (DFF / 8); idx += gridDim.x * 512) {
                const int rbi = idx / (DFF / 8), j = (idx % (DFF / 8)) * 8;
                const int b = rbi / 129, l0 = PADR + (rbi % 129) * 16;
                const bf16_t* up = U + (size_t)(b * LP + l0) * DFF2 + j;
                float w[2][3][8], bs[2][8];
#pragma unroll
                for (int q = 0; q < 2; ++q) {
#pragma unroll
                    for (int t = 0; t < 3; ++t) { const f32x4 a0 = *(const f32x4*)(cw + (size_t)t * DFF2 + q * DFF + j), a1 = *(const f32x4*)(cw + (size_t)t * DFF2 + q * DFF + j + 4);
#pragma unroll
                        for (int e = 0; e < 4; ++e) { w[q][t][e] = a0[e]; w[q][t][4 + e] = a1[e]; } }
                    const f32x4 c0 = *(const f32x4*)(cb + q * DFF + j), c1 = *(const f32x4*)(cb + q * DFF + j + 4);
#pragma unroll
                    for (int e = 0; e < 4; ++e) { bs[q][e] = c0[e]; bs[q][4 + e] = c1[e]; }
                }
                u32x4 h2[2], h1[2];
#pragma unroll
                for (int q = 0; q < 2; ++q) {
                    h2[q] = (u32x4){0u, 0u, 0u, 0u}; h1[q] = (u32x4){0u, 0u, 0u, 0u};
                    if (l0 > PADR) { h2[q] = *(const u32x4*)(up - 2 * (size_t)DFF2 + q * DFF); h1[q] = *(const u32x4*)(up - (size_t)DFF2 + q * DFF); }
                }
#pragma unroll 4
                for (int t = 0; t < 16; ++t) {
                    u32x4 h0[2];
#pragma unroll
                    for (int q = 0; q < 2; ++q) h0[q] = *(const u32x4*)(up + (size_t)t * DFF2 + q * DFF);
                    float c[2][8];
#pragma unroll
                    for (int q = 0; q < 2; ++q) {
#pragma unroll
                        for (int e2 = 0; e2 < 4; ++e2) {
                            const unsigned x2 = h2[q][e2], x1 = h1[q][e2], x0 = h0[q][e2];
                            c[q][2 * e2] = bs[q][2 * e2] + w[q][0][2 * e2] * bf2f(x2 & 0xffffu) + w[q][1][2 * e2] * bf2f(x1 & 0xffffu) + w[q][2][2 * e2] * bf2f(x0 & 0xffffu);
                            c[q][2 * e2 + 1] = bs[q][2 * e2 + 1] + w[q][0][2 * e2 + 1] * bf2f(x2 >> 16) + w[q][1][2 * e2 + 1] * bf2f(x1 >> 16) + w[q][2][2 * e2 + 1] * bf2f(x0 >> 16);
                        }
                        h2[q] = h1[q]; h1[q] = h0[q];
                    }
                    float a[8];
#pragma unroll
                    for (int e = 0; e < 8; e += 2) { const f32x2 gg = gelu_pk((f32x2){c[0][e], c[0][e + 1]}); a[e] = gg.x * c[1][e]; a[e + 1] = gg.y * c[1][e + 1]; }
                    u32x4 o; o.x = pk2(a[0], a[1]); o.y = pk2(a[2], a[3]); o.z = pk2(a[4], a[5]); o.w = pk2(a[6], a[7]);
                    *(u32x4*)(ACT + (size_t)(b * LP + l0 + t) * DFF + j) = o;
                }
            }
        }
        GSYNC();
        {
            pg8::StaticOrder S; S.init(NB * SEQ, D, gridDim.x, blockIdx.x);
            pg8::Gemm g{ACT, (const bf16_t*)(ws + WS_WDN + layer * SZ_WDN), MROWS, D, DFF};
            EpiLN E{HF, HB, (layer == 1) ? (float*)argp(ws, 22) : nullptr, argp(ws, 20) + layer * D, argp(ws, 21) + layer * D, (float*)(ws + WS_STATS), (unsigned*)(ws + WS_LNCNT) + (layer * 2 + 1) * 64, smem};
            pg8::gemm_phase(lds, g, S, E);
            if (layer == 0) meta_gemm_ln(g.A, g.Bt, DFF, E, smem);
        }
        if (layer == 0) GSYNC();
    }
}

extern "C" void kernel_launch(void* const* d_in, const int* in_sizes, int n_in, void* d_out, int out_size, void* d_ws, size_t ws_size, hipStream_t stream) {
    static int grid_blocks = 0;
    if (!grid_blocks) {
        if (n_in != 22 || ws_size < WS_END) { fprintf(stderr, "kernel_launch: unexpected n_in %d or ws %zu < %zu\n", n_in, ws_size, (size_t)WS_END); grid_blocks = -1; return; }
        int dev = 0, cus = 0, per_cu = 0;
        hipGetDevice(&dev);
        hipDeviceGetAttribute(&cus, hipDeviceAttributeMultiprocessorCount, dev);
        if (hipFuncSetAttribute((const void*)fwd_megakernel, hipFuncAttributeMaxDynamicSharedMemorySize, LDS_BYTES) != hipSuccess) fprintf(stderr, "kernel_launch: hipFuncSetAttribute failed\n");
        if (hipOccupancyMaxActiveBlocksPerMultiprocessor(&per_cu, (const void*)fwd_megakernel, 512, LDS_BYTES) != hipSuccess || per_cu < 1) { fprintf(stderr, "kernel_launch: occupancy query gave %d\n", per_cu); per_cu = 1; }
        (void)hipGetLastError();
        grid_blocks = cus * (per_cu > 1 ? 1 : per_cu);
        if (grid_blocks > 256) grid_blocks = 256;
        if (grid_blocks != 256) { fprintf(stderr, "kernel_launch: this kernel needs exactly 256 resident workgroups (got %d); nothing launched\n", grid_blocks); grid_blocks = -1; return; }
    }
    if (grid_blocks < 0) return;
    (void)hipMemsetAsync((char*)d_ws + WS_CTR, 0, WS_TA, stream);
    Params p{};
    for (int i = 0; i < 22; ++i) p.in[i] = (const float*)d_in[i];
    p.out = (float*)d_out; p.ws = (unsigned char*)d_ws;
    void* args[] = {&p};
    hipError_t e = hipLaunchCooperativeKernel((const void*)fwd_megakernel, dim3(grid_blocks), dim3(512), args, LDS_BYTES, stream);
    if (e != hipSuccess) fprintf(stderr, "cooperative launch failed: %s (grid %d)\n", hipGetErrorString(e), grid_blocks);
}
```
